# Optimizing an MI355X kernel written in HIP

```python
import jax, jax.numpy as jnp
from jax import lax
import numpy as np

D_MODEL = 1024
BATCH = 8
SEQ = 4096
DEPTH = 2

N_MIXERS = 2
N_SB = (DEPTH + 1) // 2
N_MLA = DEPTH // 2
HEAD_DIM = 64
N_SB_HEADS = 12
N_MLA_HEADS = 12
MLA_Q_RANK = 768
MLA_KV_RANK = 256
MLA_NOPE = 64
MLA_ROPE = 32
MLA_QK = MLA_NOPE + MLA_ROPE
MLA_V = 64
N_MEM = 256
N_MEM_HEADS = 4
MEM_HEAD_DIM = 64
MEM_Q = N_MEM_HEADS * MEM_HEAD_DIM
MIX_WIDTH = N_SB_HEADS * HEAD_DIM + MEM_Q
SB_IN = 3 * N_SB_HEADS * HEAD_DIM + MEM_Q
MLA_IN = MLA_Q_RANK + MLA_KV_RANK + MLA_ROPE + MEM_Q
D_FF = -(-8 * D_MODEL // (3 * 256)) * 256
Q_BLOCK = 128
ROPE_THETA = 10000.0
EPS = 1e-6

kernel_name = "hybrid_stickbreak_mla_memory_swiglu"


def _rms(x, g):
    x32 = x.astype(jnp.float32)
    y = x32 * lax.rsqrt(jnp.mean(x32 * x32, axis=-1, keepdims=True) + EPS)
    return (y * g.astype(jnp.float32)).astype(x.dtype)


def _rope(x, positions):
    half = x.shape[-1] // 2
    inv_freq = ROPE_THETA ** (-jnp.arange(half, dtype=jnp.float32) / half)
    ang = positions.astype(jnp.float32)[:, :, None, None] * inv_freq
    cos, sin = jnp.cos(ang), jnp.sin(ang)
    x32 = x.astype(jnp.float32)
    x1, x2 = x32[..., :half], x32[..., half:]
    return jnp.concatenate([x1 * cos - x2 * sin, x2 * cos + x1 * sin], axis=-1).astype(x.dtype)


def _sweep_query_blocks(block_fn, q):
    b, h, s, d = q.shape
    nb = s // Q_BLOCK
    qb = jnp.moveaxis(q.reshape(b, h, nb, Q_BLOCK, d), 2, 0)
    out = lax.map(lambda a: block_fn(a[0], a[1]), (qb, jnp.arange(nb)))
    return jnp.moveaxis(out, 0, 2).reshape(b, h, s, out.shape[-1])


def _stick_breaking(q, k, v):
    s_len = k.shape[2]
    scale = q.shape[-1] ** -0.5
    key_pos = jnp.arange(s_len)[None, :]

    def block(q_blk, blk):
        z = jnp.einsum('bhqd,bhkd->bhqk', q_blk, k).astype(jnp.float32) * scale
        q_pos = blk * Q_BLOCK + jnp.arange(Q_BLOCK)[:, None]
        strict = key_pos < q_pos
        log_fail = jnp.where(strict, jax.nn.log_sigmoid(-z), 0.0)
        after = lax.cumsum(log_fail, axis=3, reverse=True) - log_fail
        w = jnp.where(strict, jnp.exp(jax.nn.log_sigmoid(z) + after), 0.0)
        return jnp.einsum('bhqk,bhkd->bhqd', w.astype(v.dtype), v)

    return _sweep_query_blocks(block, q)


def _causal_softmax_attn(q, k, v):
    s_len = k.shape[2]
    scale = q.shape[-1] ** -0.5
    key_pos = jnp.arange(s_len)[None, :]

    def block(q_blk, blk):
        sc = jnp.einsum('bhqd,bhkd->bhqk', q_blk, k).astype(jnp.float32) * scale
        q_pos = blk * Q_BLOCK + jnp.arange(Q_BLOCK)[:, None]
        sc = jnp.where(key_pos <= q_pos, sc, -jnp.inf)
        p = jax.nn.softmax(sc, axis=-1)
        return jnp.einsum('bhqk,bhkd->bhqd', p.astype(v.dtype), v)

    return _sweep_query_blocks(block, q)


def _memory_heads(q_flat, mem, ln_g, w_kv, g_qn, g_kn):
    b, s, _ = q_flat.shape
    q = _rms(q_flat.reshape(b, s, N_MEM_HEADS, MEM_HEAD_DIM), g_qn)
    kv = (_rms(mem, ln_g) @ w_kv).reshape(b, mem.shape[1], N_MEM_HEADS, 2 * MEM_HEAD_DIM)
    k = _rms(kv[..., :MEM_HEAD_DIM], g_kn)
    v = kv[..., MEM_HEAD_DIM:]
    sc = jnp.einsum('bqhd,bkhd->bhqk', q, k).astype(jnp.float32) * (MEM_HEAD_DIM ** -0.5)
    p = jax.nn.softmax(sc, axis=-1)
    o = jnp.einsum('bhqk,bkhd->bqhd', p.astype(v.dtype), v)
    return o.reshape(b, s, MEM_Q)


def _heads_first(t, n_heads):
    b, s, _ = t.shape
    return t.reshape(b, s, n_heads, -1).transpose(0, 2, 1, 3)


def setup_inputs(seed: int = 0) -> dict:
    key = jax.random.key(seed)
    ks = iter(jax.random.split(key, 32))

    def w(shape, fan_in, extra=1.0):
        return jax.random.normal(next(ks), shape, jnp.float32) * (fan_in ** -0.5) * extra

    def gain(shape):
        return 1.0 + 0.05 * jax.random.normal(next(ks), shape, jnp.float32)

    res_scale = (2.0 * DEPTH) ** -0.5
    x = jax.random.normal(next(ks), (BATCH, SEQ, D_MODEL), jnp.float32)
    mem = jax.random.normal(next(ks), (BATCH, N_MEM, D_MODEL), jnp.float32)
    offset = jax.random.randint(next(ks), (BATCH, 1), 0, 1024, dtype=jnp.int32)
    positions = offset + jnp.arange(SEQ, dtype=jnp.int32)[None, :]
    return {
        "x": x,
        "mem": mem,
        "positions": positions,
        "ln_attn": gain((DEPTH, D_MODEL)),
        "w_out": w((DEPTH, MIX_WIDTH, D_MODEL), MIX_WIDTH, res_scale),
        "ln_mem": gain((DEPTH, D_MODEL)),
        "w_mem_kv": w((DEPTH, D_MODEL, 2 * MEM_Q), D_MODEL),
        "g_qn_mem": gain((DEPTH, MEM_HEAD_DIM)),
        "g_kn_mem": gain((DEPTH, MEM_HEAD_DIM)),
        "ln_ffn": gain((DEPTH, D_MODEL)),
        "w_ffn_gu": w((DEPTH, D_MODEL, 2 * D_FF), D_MODEL),
        "w_ffn_down": w((DEPTH, D_FF, D_MODEL), D_FF, res_scale),
        "sb_w_in": w((N_SB, D_MODEL, SB_IN), D_MODEL),
        "mla_w_in": w((N_MLA, D_MODEL, MLA_IN), D_MODEL),
        "mla_q_norm": gain((N_MLA, MLA_Q_RANK)),
        "mla_w_q_up": w((N_MLA, MLA_Q_RANK, N_MLA_HEADS * MLA_QK), MLA_Q_RANK),
        "mla_kv_norm": gain((N_MLA, MLA_KV_RANK)),
        "mla_w_kv_up": w((N_MLA, MLA_KV_RANK, N_MLA_HEADS * (MLA_NOPE + MLA_V)), MLA_KV_RANK),
        "mla_g_qn": gain((N_MLA, MLA_QK)),
        "mla_g_kn": gain((N_MLA, MLA_QK)),
    }


def reference(x, mem, positions, ln_attn, w_out, ln_mem, w_mem_kv, g_qn_mem, g_kn_mem,
              ln_ffn, w_ffn_gu, w_ffn_down, sb_w_in, mla_w_in, mla_q_norm, mla_w_q_up,
              mla_kv_norm, mla_w_kv_up, mla_g_qn, mla_g_kn):
    b, s, _ = x.shape
    for i in range(DEPTH):
        h = _rms(x, ln_attn[i])
        j = i // N_MIXERS
        if i % N_MIXERS == 0:
            proj = h @ sb_w_in[j]
            wq = N_SB_HEADS * HEAD_DIM
            q = _heads_first(proj[..., :wq], N_SB_HEADS)
            k = _heads_first(proj[..., wq:2 * wq], N_SB_HEADS)
            v = _heads_first(proj[..., 2 * wq:3 * wq], N_SB_HEADS)
            q_mem = proj[..., 3 * wq:]
            o = _stick_breaking(q, k, v)
        else:
            proj = h @ mla_w_in[j]
            c_q = proj[..., :MLA_Q_RANK]
            c_kv = proj[..., MLA_Q_RANK:MLA_Q_RANK + MLA_KV_RANK]
            k_rope = proj[..., MLA_Q_RANK + MLA_KV_RANK:MLA_Q_RANK + MLA_KV_RANK + MLA_ROPE]
            q_mem = proj[..., MLA_Q_RANK + MLA_KV_RANK + MLA_ROPE:]
            q = (_rms(c_q, mla_q_norm[j]) @ mla_w_q_up[j]).reshape(b, s, N_MLA_HEADS, MLA_QK)
            kv = (_rms(c_kv, mla_kv_norm[j]) @ mla_w_kv_up[j]).reshape(
                b, s, N_MLA_HEADS, MLA_NOPE + MLA_V)
            k_rope_h = jnp.broadcast_to(k_rope[:, :, None, :], (b, s, N_MLA_HEADS, MLA_ROPE))
            k = jnp.concatenate([kv[..., :MLA_NOPE], k_rope_h], axis=-1)
            v = kv[..., MLA_NOPE:]
            q = _rms(q, mla_g_qn[j])
            k = _rms(k, mla_g_kn[j])
            q = jnp.concatenate([q[..., :MLA_NOPE], _rope(q[..., MLA_NOPE:], positions)], -1)
            k = jnp.concatenate([k[..., :MLA_NOPE], _rope(k[..., MLA_NOPE:], positions)], -1)
            o = _causal_softmax_attn(q.transpose(0, 2, 1, 3), k.transpose(0, 2, 1, 3),
                                     v.transpose(0, 2, 1, 3))
        mixer_out = o.transpose(0, 2, 1, 3).reshape(b, s, -1)
        mem_out = _memory_heads(q_mem, mem, ln_mem[i], w_mem_kv[i], g_qn_mem[i], g_kn_mem[i])
        x = x + jnp.concatenate([mixer_out, mem_out], axis=-1) @ w_out[i]
        gu = _rms(x, ln_ffn[i]) @ w_ffn_gu[i]
        x = x + (jax.nn.silu(gu[..., :D_FF]) * gu[..., D_FF:]) @ w_ffn_down[i]
    return x
```

```cpp
#include <hip/hip_runtime.h>
#include <hip/hip_cooperative_groups.h>
#include <cstdint>
#include <cstdio>
#include <cmath>
#include <cstring>
namespace cg = cooperative_groups;

#define DI __device__ __forceinline__
typedef unsigned short bf16_t;
typedef short bf16x8 __attribute__((ext_vector_type(8)));
typedef short s16x4 __attribute__((ext_vector_type(4)));
typedef float f32x16 __attribute__((ext_vector_type(16)));
typedef float f32x4 __attribute__((ext_vector_type(4)));
typedef float f32x2 __attribute__((ext_vector_type(2)));
typedef unsigned u32x4 __attribute__((ext_vector_type(4)));
typedef unsigned u32x2 __attribute__((ext_vector_type(2)));
typedef __bf16 bf2_t __attribute__((ext_vector_type(2)));

constexpr int T_TOK = 32768, SEQ = 4096, NBATCH = 8, DM = 1024, DFF = 2816, NMEM = 256;
constexpr int NTHREADS = 512;
constexpr int LDS_BYTES = 131072 + 4096;
constexpr float EPS = 1e-6f;

constexpr size_t SZ_SBIN = (size_t)2560 * 1024 * 2, SZ_OUT = (size_t)1024 * 1024 * 2, SZ_MKV = (size_t)512 * 1024 * 2,
                 SZ_GU = (size_t)5632 * 1024 * 2, SZ_DN = (size_t)1024 * 2816 * 2, SZ_MLAIN = (size_t)1536 * 1024 * 2,
                 SZ_QUP = (size_t)1280 * 768 * 2, SZ_KVUP = (size_t)1536 * 256 * 2;
constexpr size_t O_SBIN = 0, O_OUT0 = O_SBIN + SZ_SBIN, O_OUT1 = O_OUT0 + SZ_OUT, O_MKV0 = O_OUT1 + SZ_OUT, O_MKV1 = O_MKV0 + SZ_MKV,
                 O_GU0 = O_MKV1 + SZ_MKV, O_GU1 = O_GU0 + SZ_GU, O_DN0 = O_GU1 + SZ_GU, O_DN1 = O_DN0 + SZ_DN, O_MLAIN = O_DN1 + SZ_DN,
                 O_QUP = O_MLAIN + SZ_MLAIN, O_KVUP = O_QUP + SZ_QUP, O_XB = O_KVUP + SZ_KVUP;
constexpr size_t SZ_XB = (size_t)T_TOK * 1024 * 2;
constexpr size_t O_MIX = O_XB + SZ_XB, O_MEMN = O_MIX + SZ_XB, O_KMRAW = O_MEMN + (size_t)2048 * 1024 * 2,
                 O_KM = O_KMRAW + (size_t)2 * 2048 * 512 * 2, O_PS1 = O_KM + (size_t)2 * 2048 * 256 * 2,
                 O_PS2 = O_PS1 + (size_t)T_TOK * 16 * 4, O_BAR = O_PS2 + (size_t)T_TOK * 16 * 4, O_ARENA = O_BAR + 16384;
constexpr size_t O_P = O_ARENA;
constexpr size_t O_PM = O_ARENA, O_QB = O_PM + (size_t)T_TOK * 1408 * 2, O_KN = O_QB + (size_t)T_TOK * 1152 * 2,
                 O_V1 = O_KN + (size_t)T_TOK * 1152 * 2, O_END = O_V1 + (size_t)T_TOK * 768 * 2;
constexpr size_t O_ACT = O_ARENA;
static_assert(O_END <= (size_t)512 * 1024 * 1024, "workspace map exceeds 512 MiB");

struct Params {
  const float *x, *mem; const int* pos;
  const float *ln_attn, *w_out, *ln_mem, *w_mem_kv, *g_qn_mem, *g_kn_mem, *ln_ffn, *w_ffn_gu, *w_ffn_down, *sb_w_in, *mla_w_in,
      *mla_q_norm, *mla_w_q_up, *mla_kv_norm, *mla_w_kv_up, *mla_g_qn, *mla_g_kn;
  float* out; char* ws;
};

DI int launder_tid() { int t = threadIdx.x; asm volatile("" : "+v"(t)); return t; }
DI unsigned pack2(float a, float b) { bf2_t v = __builtin_convertvector((f32x2){a, b}, bf2_t); return __builtin_bit_cast(unsigned, v); }
DI bf16_t tobf(float a) { return (bf16_t)(pack2(a, 0.f) & 0xffffu); }
DI float bf2f(bf16_t v) { return __uint_as_float(((unsigned)v) << 16); }
#define MFMA32(a, b, c) __builtin_amdgcn_mfma_f32_32x32x16_bf16((a), (b), (c), 0, 0, 0)
#define XB_TMO      128
#define XB_XCNT(j)  (256  + 64 * (j))
#define XB_XSUB(j)  (1280 + 64 * (j))
#define XB_XGEN(j)  (2304 + 64 * (j))
#define XB_TOP      3328
#define XB_TOPGEN   3392
#define XCD_BAR_WORDS 3456
#define XB_SPIN_CAP (1u << 20)
#define LAS __attribute__((address_space(3)))
DI unsigned xb_ld(unsigned* p) { return __hip_atomic_load(p, __ATOMIC_RELAXED, __HIP_MEMORY_SCOPE_AGENT); }
DI unsigned xb_add(unsigned* p, unsigned v) { return __hip_atomic_fetch_add(p, v, __ATOMIC_RELAXED, __HIP_MEMORY_SCOPE_AGENT); }
DI unsigned xb_xcc_id() { return (unsigned)__builtin_amdgcn_s_getreg((3 << 11) | 20) & 0xFu; }
#define XB_SPIN(cond, bar) do { unsigned _sp = 0; while (cond) { __builtin_amdgcn_s_sleep(1); \
    if ((++_sp & 255u) == 0u) { if (xb_ld(&(bar)[XB_TMO])) break; if (_sp > XB_SPIN_CAP) { atomicAdd(&(bar)[XB_TMO], 1u); break; } } } } while (0)
struct XcdBarrier { unsigned* bar; unsigned x; volatile LAS unsigned* st; };
DI XcdBarrier xcd_barrier_post(unsigned* bar, volatile LAS unsigned* st) {
  XcdBarrier b; b.bar = bar; b.x = xb_xcc_id(); b.st = st;
  if (threadIdx.x == 0) (void)xb_add(&bar[XB_XCNT(b.x)], 1u);
  return b;
}
DI void xcd_barrier_complete(unsigned* bar, unsigned x, unsigned& nloc, unsigned& nx) {
  const unsigned G = gridDim.x * gridDim.y * gridDim.z;
  unsigned sum, cnt, mine, sp = 0u;
  for (;;) {
    sum = 0u; cnt = 0u; mine = 0u;
#pragma unroll
    for (unsigned j = 0; j < 16; ++j) { const unsigned c = xb_ld(&bar[XB_XCNT(j)]); sum += c; cnt += (c > 0u) ? 1u : 0u; mine = (j == x) ? c : mine; }
    if (sum == G) break;
    __builtin_amdgcn_s_sleep(1);
    if ((++sp & 255u) == 0u) { if (xb_ld(&bar[XB_TMO])) break; if (sp > XB_SPIN_CAP) { atomicAdd(&bar[XB_TMO], 1u); break; } }
  }
  nloc = mine > 0u ? mine : 1u; nx = cnt > 0u ? cnt : 1u;
}
DI void xcd_barrier(const XcdBarrier& b) {
  asm volatile("s_waitcnt vmcnt(0)" ::: "memory");
  __syncthreads();
  if (threadIdx.x == 0) {
    unsigned* bar = b.bar;
    __builtin_amdgcn_s_waitcnt(0);
    unsigned nloc = b.st[0], nx = b.st[1];
    if (nloc == 0u) { xcd_barrier_complete(bar, b.x, nloc, nx); b.st[0] = nloc; b.st[1] = nx; }
    const unsigned old = xb_add(&bar[XB_XSUB(b.x)], 1u);
    const unsigned gen = old / nloc;
    if (old + 1u == (gen + 1u) * nloc) {
      __builtin_amdgcn_fence(__ATOMIC_RELEASE, "agent");
      asm volatile("s_waitcnt vmcnt(0)" ::: "memory");
      const unsigned og = xb_add(&bar[XB_TOP], 1u);
      const unsigned tg = og / nx;
      if (og + 1u == (tg + 1u) * nx) xb_add(&bar[XB_TOPGEN], 1u);
      else XB_SPIN(xb_ld(&bar[XB_TOPGEN]) == tg, bar);
      __builtin_amdgcn_fence(__ATOMIC_ACQUIRE, "agent");
      xb_add(&bar[XB_XGEN(b.x)], 1u);
      asm volatile("s_waitcnt vmcnt(0)" ::: "memory");
    } else {
      XB_SPIN(xb_ld(&bar[XB_XGEN(b.x)]) == gen, bar);
      __builtin_amdgcn_fence(__ATOMIC_ACQUIRE, "agent");
      asm volatile("s_waitcnt vmcnt(0)" ::: "memory");
    }
  }
  __syncthreads();
}


template <bool HASG>
DI void transpose_job(const float* __restrict__ W, const float* __restrict__ g, bf16_t* __restrict__ Bt, int K, int N, int Npad, int perm,
                      char* smem, int& toff) {
  const int nk = K >> 6, nn = Npad >> 6, ntiles = nk * nn, G = gridDim.x, tid = launder_tid();
  const int nl = tid & 63, kq = tid >> 6;
  int start = (int)((blockIdx.x + G - (toff % G)) % G);
  for (int t = start; t < ntiles; t += 2 * G) {
    float v[2][8];
    bool okv[2]; int n0v[2], k0v[2];
#pragma unroll
    for (int u = 0; u < 2; ++u) {
      int tt = t + u * G; if (tt >= ntiles) tt = t;
      const int ntile = tt / nk, kt = tt - ntile * nk, n0 = ntile * 64, k0 = kt * 64;
      n0v[u] = n0; k0v[u] = k0;
      const int n = n0 + nl;
      int src = n;
      if (perm) src = (((n >> 7) & 1) ? DFF : 0) + (n >> 8) * 128 + (n & 127);
      okv[u] = n < N;
      if (!okv[u]) src = N - 1;
      const float* wp = W + (size_t)(k0 + kq) * N + src;
#pragma unroll
      for (int i = 0; i < 8; ++i) v[u][i] = wp[(size_t)(8 * i) * N];
    }
#pragma unroll
    for (int u = 0; u < 2; ++u) {
      bf16_t* sm = (bf16_t*)smem + u * (64 * 72);
      if (HASG) {
#pragma unroll
        for (int i = 0; i < 8; ++i) v[u][i] *= g[k0v[u] + kq + 8 * i];
      }
#pragma unroll
      for (int i = 0; i < 8; ++i) sm[nl * 72 + kq + 8 * i] = tobf(okv[u] ? v[u][i] : 0.f);
    }
    __syncthreads();
#pragma unroll
    for (int u = 0; u < 2; ++u) {
      const bf16_t* sm = (const bf16_t*)smem + u * (64 * 72);
      const int row = tid >> 3, kc = tid & 7;
      u32x4 vv = *(const u32x4*)(sm + row * 72 + kc * 8);
      *(u32x4*)(Bt + (size_t)(n0v[u] + row) * K + k0v[u] + kc * 8) = vv;
    }
    __syncthreads();
  }
  toff += ntiles;
}

DI void convert_rows(const float* __restrict__ X, bf16_t* __restrict__ XB, int rows, bool norm, float* __restrict__ ps) {
  const int tidc = launder_tid();
  const int lane = tidc & 63, wave = tidc >> 6;
  const int stride = gridDim.x * 8;
  for (int row0 = blockIdx.x * 8 + wave; row0 < rows; row0 += 2 * stride) {
    f32x4 v[2][4];
    int rw[2];
#pragma unroll
    for (int u = 0; u < 2; ++u) {
      int row = row0 + u * stride; if (row >= rows) row = row0;
      rw[u] = row;
      const float* xr = X + (size_t)row * DM;
#pragma unroll
      for (int i = 0; i < 4; ++i) v[u][i] = *(const f32x4*)(xr + i * 256 + lane * 4);
    }
#pragma unroll
    for (int u = 0; u < 2; ++u) {
      float ss = 0.f;
#pragma unroll
      for (int i = 0; i < 4; ++i) ss += v[u][i][0] * v[u][i][0] + v[u][i][1] * v[u][i][1] + v[u][i][2] * v[u][i][2] + v[u][i][3] * v[u][i][3];
#pragma unroll
      for (int o = 32; o >= 1; o >>= 1) ss += __shfl_xor(ss, o);
      float sc = 1.f;
      if (norm) sc = rsqrtf(ss * (1.f / DM) + EPS);
      if (ps && lane < 16) ps[(size_t)rw[u] * 16 + lane] = lane == 0 ? ss : 0.f;
#pragma unroll
      for (int i = 0; i < 4; ++i) {
        u32x2 w; w.x = pack2(v[u][i][0] * sc, v[u][i][1] * sc); w.y = pack2(v[u][i][2] * sc, v[u][i][3] * sc);
        *(u32x2*)(XB + (size_t)rw[u] * DM + i * 256 + lane * 4) = w;
      }
    }
  }
}

namespace pg8 {
#define PG8_LAS __attribute__((address_space(3)))
constexpr int BM = 256, BK = 64, HALF = 128, HTB = HALF * BK * 2, STAGE_BYTES = 8 * HTB;
DI int lds_byte(int r, int c) { const int st = (r >> 4) * 2 + (c >> 5), rr = r & 15, cc = c & 31, ob = rr * 64 + cc * 2; return st * 1024 + (ob ^ (((ob >> 9) & 1) << 5)); }
DI void stage_rc(int b, int& R, int& C) { const int st = b / 1024, sb = b % 1024, swz = sb ^ (((sb >> 9) & 1) << 5); R = (st >> 1) * 16 + swz / 64; C = (st & 1) * 32 + (swz % 64) / 2; }
DI int perm32(int rho) { const int n = rho >> 4, i = rho & 15; return 8 * (i >> 2) + 4 * n + (i & 3); }
struct Unit { int pm, pn; };
struct Gemm { const bf16_t* A; int lda; const bf16_t* Bt; int M, N, K; };

struct XOrder {
  int nN, G, xcd, mper, gms, ntl, rot;
  DI void init(int M, int N, int& toff) {
    const int nM = M / BM; nN = N / BM; G = (int)(gridDim.x >> 3); xcd = (int)(blockIdx.x & 7); const int lb = (int)(blockIdx.x >> 3);
    mper = nM >> 3; gms = mper < 4 ? mper : 4; ntl = mper * nN; rot = (lb + G - (toff % G)) % G; toff += ntl;
  }
  DI bool next(int i, Unit& u) const {
    const int j = rot + i * G; if (j >= ntl) return false;
    const int mg = j / (gms * nN), rem = j - mg * (gms * nN); u.pn = rem / gms; u.pm = xcd * mper + mg * gms + (rem - u.pn * gms); return true;
  }
};

DI void rows_rstd(float (&rs)[2][4], const float* ps, const Unit& u, int wr, int fr, int fq, int p_lo, int p_hi, float inv_dim) {
  f32x4 pv[2][4];
#pragma unroll
  for (int ai = 0; ai < 2; ++ai)
#pragma unroll
    for (int m = 0; m < 4; ++m) pv[ai][m] = *(const f32x4*)(ps + (size_t)(u.pm * BM + ai * HALF + wr * 64 + m * 16 + fr) * 16 + 4 * fq);
  const bool use = (4 * fq >= p_lo) && (4 * fq < p_hi);
#pragma unroll
  for (int ai = 0; ai < 2; ++ai)
#pragma unroll
    for (int m = 0; m < 4; ++m) {
      float s = use ? (pv[ai][m][0] + pv[ai][m][1]) + (pv[ai][m][2] + pv[ai][m][3]) : 0.f;
      s += __shfl_xor(s, 16); s += __shfl_xor(s, 32);
      rs[ai][m] = rsqrtf(s * inv_dim + EPS);
    }
}
enum { EM_PLAIN = 0, EM_KVUP = 1 };
template <int EMODE, bool PSOUT = false> struct EpiNorm {
  static constexpr bool PERM = true, AFTER_DRAIN = false;
  bf16_t* O; int ldo; int ncols; bf16_t* O2; const float* ps_in; int p_lo, p_hi; float inv_dim; float* ps_out;
  DI void operator()(const f32x4 (&acc)[2][2][4][2], const Unit& u, int wr, int wc, int fr, int fq) const {
    float rsv[2][4];
    if (ps_in) rows_rstd(rsv, ps_in, u, wr, fr, fq, p_lo, p_hi, inv_dim);
#pragma unroll
    for (int ai = 0; ai < 2; ++ai)
#pragma unroll
      for (int m = 0; m < 4; ++m) {
        const int row = u.pm * BM + ai * HALF + wr * 64 + m * 16 + fr;
        const float rs = ps_in ? rsv[ai][m] : 1.f;
        float ssum = 0.f;
#pragma unroll
        for (int bj = 0; bj < 2; ++bj) {
          const int c0 = u.pn * BM + bj * HALF + wc * 32 + 8 * fq;
          const f32x4 v0 = acc[ai][bj][m][0] * rs, v1 = acc[ai][bj][m][1] * rs;
          if (PSOUT) ssum += (v0[0] * v0[0] + v0[1] * v0[1]) + (v0[2] * v0[2] + v0[3] * v0[3]) + (v1[0] * v1[0] + v1[1] * v1[1]) + (v1[2] * v1[2] + v1[3] * v1[3]);
          u32x4 w; w.x = pack2(v0[0], v0[1]); w.y = pack2(v0[2], v0[3]); w.z = pack2(v1[0], v1[1]); w.w = pack2(v1[2], v1[3]);
          if (EMODE == EM_KVUP) {
            const int hh = c0 >> 7, j = c0 & 127;
            if (j < 64) *(u32x4*)(O + (size_t)row * 1152 + hh * 96 + j) = w; else *(u32x4*)(O2 + (size_t)row * 768 + hh * 64 + (j - 64)) = w;
          } else {
            if (c0 < ncols) *(u32x4*)(O + (size_t)row * ldo + c0) = w;
          }
        }
        if (PSOUT) { ssum += __shfl_xor(ssum, 16); ssum += __shfl_xor(ssum, 32); if (fq == 0 && u.pn < 4) ps_out[(size_t)row * 16 + u.pn * 4 + wc] = ssum; }
      }
  }
};
struct EpiSwiglu {
  static constexpr bool PERM = true, AFTER_DRAIN = false;
  bf16_t* O; const float* ps_in;
  DI void operator()(const f32x4 (&acc)[2][2][4][2], const Unit& u, int wr, int wc, int fr, int fq) const {
    float rsv[2][4];
    rows_rstd(rsv, ps_in, u, wr, fr, fq, 0, 16, 1.f / 1024.f);
#pragma unroll
    for (int ai = 0; ai < 2; ++ai)
#pragma unroll
      for (int m = 0; m < 4; ++m) {
        const int row = u.pm * BM + ai * HALF + wr * 64 + m * 16 + fr;
        const float rs = rsv[ai][m];
        float o[8];
#pragma unroll
        for (int n = 0; n < 2; ++n)
#pragma unroll
          for (int c = 0; c < 4; ++c) {
            const float gv = acc[ai][0][m][n][c] * rs, uv = acc[ai][1][m][n][c] * rs;
            o[4 * n + c] = gv * __builtin_amdgcn_rcpf(1.f + __expf(-gv)) * uv;
          }
        u32x4 w; w.x = pack2(o[0], o[1]); w.y = pack2(o[2], o[3]); w.z = pack2(o[4], o[5]); w.w = pack2(o[6], o[7]);
        *(u32x4*)(O + (size_t)row * DFF + u.pn * HALF + wc * 32 + 8 * fq) = w;
      }
  }
};
template <bool FIRST, bool LAST> struct EpiResid {
  static constexpr bool PERM = true, AFTER_DRAIN = false;
  const float* xin32; bf16_t* xb; float* xout32; float* ps_out;
  DI void operator()(const f32x4 (&acc)[2][2][4][2], const Unit& u, int wr, int wc, int fr, int fq) const {
    const int row0 = u.pm * BM + wr * 64 + fr;
    const size_t base = (size_t)row0 * DM + u.pn * BM + wc * 32 + 8 * fq;
    f32x4 xv[2][4];
    u32x4 xh[2][2];
#define RES_LD(I) { const size_t o_ = base + (size_t)((((I) >> 2) * HALF) + ((I) & 3) * 16) * DM; \
    if (FIRST) { const float* p_ = xin32 + o_; xv[(I) & 1][0] = *(const f32x4*)p_; xv[(I) & 1][1] = *(const f32x4*)(p_ + 4); xv[(I) & 1][2] = *(const f32x4*)(p_ + HALF); xv[(I) & 1][3] = *(const f32x4*)(p_ + HALF + 4); } \
    else { xh[(I) & 1][0] = *(const u32x4*)(xb + o_); xh[(I) & 1][1] = *(const u32x4*)(xb + o_ + HALF); } }
    RES_LD(0)
#pragma unroll
    for (int i = 0; i < 8; ++i) {
      const int ai = i >> 2, m = i & 3;
      if (i + 1 < 8) RES_LD(i + 1)
      __builtin_amdgcn_sched_barrier(0);
      const size_t idx = base + (size_t)(ai * HALF + m * 16) * DM;
      float ssum = 0.f;
#pragma unroll
      for (int bj = 0; bj < 2; ++bj) {
        f32x4 x0, x1;
        if (FIRST) { x0 = xv[i & 1][2 * bj]; x1 = xv[i & 1][2 * bj + 1]; }
        else {
          const u32x4 hw = xh[i & 1][bj];
          x0 = (f32x4){__uint_as_float(hw.x << 16), __uint_as_float(hw.x & 0xffff0000u), __uint_as_float(hw.y << 16), __uint_as_float(hw.y & 0xffff0000u)};
          x1 = (f32x4){__uint_as_float(hw.z << 16), __uint_as_float(hw.z & 0xffff0000u), __uint_as_float(hw.w << 16), __uint_as_float(hw.w & 0xffff0000u)};
        }
        const f32x4 v0 = x0 + acc[ai][bj][m][0], v1 = x1 + acc[ai][bj][m][1];
        if (LAST) { *(f32x4*)(xout32 + idx + bj * HALF) = v0; *(f32x4*)(xout32 + idx + bj * HALF + 4) = v1; }
        else {
          ssum += (v0[0] * v0[0] + v0[1] * v0[1]) + (v0[2] * v0[2] + v0[3] * v0[3]) + (v1[0] * v1[0] + v1[1] * v1[1]) + (v1[2] * v1[2] + v1[3] * v1[3]);
          u32x4 w; w.x = pack2(v0[0], v0[1]); w.y = pack2(v0[2], v0[3]); w.z = pack2(v1[0], v1[1]); w.w = pack2(v1[2], v1[3]);
          *(u32x4*)(xb + idx + bj * HALF) = w;
        }
      }
      if (!LAST) {
        ssum += __shfl_xor(ssum, 16); ssum += __shfl_xor(ssum, 32);
        if (fq == 0) ps_out[(size_t)(row0 + ai * HALF + m * 16) * 16 + u.pn * 4 + wc] = ssum;
      }
      __builtin_amdgcn_sched_barrier(0);
    }
#undef RES_LD
  }
};

template <class Epi, class Sched>
DI void gemm_phase(PG8_LAS unsigned char* lds, const Gemm g, const Sched& S, const Epi& E) {
  const int tid = launder_tid(), wid = __builtin_amdgcn_readfirstlane(tid >> 6), lane = tid & 63, wr = wid >> 2, wc = wid & 3, fr = lane & 15, fq = lane >> 4;
  const int K = g.K, nt = K / BK;
  unsigned voffA[2], voffB[2];
#pragma unroll
  for (int i = 0; i < 2; ++i) { int R, C; stage_rc(tid * 16 + i * 8192, R, C); const int Rb = Epi::PERM ? ((R & ~31) + perm32(R & 31)) : R;
    voffA[i] = (unsigned)(R * g.lda + C) * 2u; voffB[i] = (unsigned)(Rb * K + C) * 2u; }
  const size_t kstep = (size_t)(BK * 2);
  const size_t hstepA = (size_t)HALF * g.lda * 2, hstepB = (size_t)HALF * K * 2;
  const size_t tstepA = 2 * hstepA, tstepB = 2 * hstepB;
  const unsigned ldsw = (unsigned)wid * 1024u;
  const int aoff = lds_byte(wr * 64 + fr, fq * 8), boff = lds_byte(wc * 32 + fr, fq * 8);
#define PG8_SA(b, h) (((b) * 2 + (h)) * HTB)
#define PG8_SB(b, h) ((4 + (b) * 2 + (h)) * HTB)
#define PG8_STAGE(bufoff, gbase, voff) do { _Pragma("unroll") for (int _i = 0; _i < 2; ++_i) \
    __builtin_amdgcn_global_load_lds((const unsigned*)((const char*)(gbase) + (voff)[_i]), (PG8_LAS unsigned*)(lds + (bufoff) + ldsw + _i * 8192), 16, 0, 0); } while (0)
#define PG8_LDA(dst, b, h) do { _Pragma("unroll") for (int m = 0; m < 4; ++m) _Pragma("unroll") for (int k = 0; k < 2; ++k) dst[m][k] = *(const PG8_LAS bf16x8*)(lds + PG8_SA(b, h) + aoff + m * 2048 + k * 1024); } while (0)
#define PG8_LDB(dst, b, h) do { _Pragma("unroll") for (int n = 0; n < 2; ++n) _Pragma("unroll") for (int k = 0; k < 2; ++k) dst[n][k] = *(const PG8_LAS bf16x8*)(lds + PG8_SB(b, h) + boff + n * 2048 + k * 1024); } while (0)
#define PG8_MMA(ai, bj, At, Bt) do { __builtin_amdgcn_s_setprio(1); _Pragma("unroll") for (int m = 0; m < 4; ++m) _Pragma("unroll") for (int n = 0; n < 2; ++n) _Pragma("unroll") for (int k = 0; k < 2; ++k) \
    acc[ai][bj][m][n] = __builtin_amdgcn_mfma_f32_16x16x32_bf16(Bt[n][k], At[m][k], acc[ai][bj][m][n], 0, 0, 0); __builtin_amdgcn_s_setprio(0); } while (0)
#define PG8_WAIT_V(n) asm volatile("s_waitcnt vmcnt(" #n ")" ::: "memory")
#define PG8_WAIT_L(n) asm volatile("s_waitcnt lgkmcnt(" #n ")" ::: "memory")
#define PG8_BAR __builtin_amdgcn_s_barrier()
#define PG8_SCHED __builtin_amdgcn_sched_barrier(0)
  Unit cur, nxt; int ui = 0;
  if (!S.next(0, cur)) return;
  f32x4 acc[2][2][4][2];
#pragma unroll
  for (int a = 0; a < 2; ++a)
#pragma unroll
    for (int b = 0; b < 2; ++b)
#pragma unroll
      for (int m = 0; m < 4; ++m)
#pragma unroll
        for (int n = 0; n < 2; ++n) acc[a][b][m][n] = (f32x4){0.f, 0.f, 0.f, 0.f};
  bf16x8 At[4][2], B0[2][2], B1[2][2];
  const char* cA = (const char*)g.A + (size_t)cur.pm * tstepA; const char* cB = (const char*)g.Bt + (size_t)cur.pn * tstepB;
  PG8_STAGE(PG8_SB(0, 0), cB, voffB); PG8_STAGE(PG8_SB(0, 1), cB + hstepB, voffB); PG8_STAGE(PG8_SA(0, 0), cA, voffA); PG8_STAGE(PG8_SA(0, 1), cA + hstepA, voffA);
  if (wr == 1) PG8_BAR;
  PG8_WAIT_V(2); PG8_BAR;
  PG8_STAGE(PG8_SB(1, 0), cB + kstep, voffB); PG8_STAGE(PG8_SA(1, 0), cA + kstep, voffA); PG8_STAGE(PG8_SB(1, 1), cB + hstepB + kstep, voffB);
  PG8_WAIT_V(6); PG8_BAR;
  for (;;) {
    const bool has_next = S.next(ui + 1, nxt);
    const char* nA = has_next ? (const char*)g.A + (size_t)nxt.pm * tstepA : cA; const char* nB = has_next ? (const char*)g.Bt + (size_t)nxt.pn * tstepB : cB;
#pragma unroll 1
    for (int t = 0; t < nt; t += 2) {
      const bool last = (t == nt - 2);
      const char* a1 = cA + (size_t)(t + 1) * kstep;
      const char* a2 = last ? nA : cA + (size_t)(t + 2) * kstep; const char* b2 = last ? nB : cB + (size_t)(t + 2) * kstep;
      const char* a3 = a2 + kstep; const char* b3 = b2 + kstep;
      PG8_LDB(B0, 0, 0); PG8_LDB(B1, 0, 1); PG8_SCHED; PG8_LDA(At, 0, 0); PG8_STAGE(PG8_SA(1, 1), a1 + hstepA, voffA);
      PG8_WAIT_V(8); PG8_WAIT_L(0); PG8_BAR; PG8_MMA(0, 0, At, B0); PG8_MMA(0, 1, At, B1); PG8_BAR; PG8_SCHED;
      PG8_LDA(At, 0, 1); PG8_STAGE(PG8_SB(0, 0), b2, voffB); PG8_STAGE(PG8_SB(0, 1), b2 + hstepB, voffB); PG8_STAGE(PG8_SA(0, 0), a2, voffA);
      PG8_WAIT_V(8); PG8_WAIT_L(0); PG8_BAR; PG8_MMA(1, 0, At, B0); PG8_MMA(1, 1, At, B1); PG8_BAR; PG8_SCHED;
      PG8_LDB(B0, 1, 0); PG8_LDB(B1, 1, 1); PG8_SCHED; PG8_LDA(At, 1, 0); PG8_STAGE(PG8_SA(0, 1), a2 + hstepA, voffA);
      PG8_WAIT_V(8); PG8_WAIT_L(0); PG8_BAR; PG8_MMA(0, 0, At, B0); PG8_MMA(0, 1, At, B1); PG8_BAR; PG8_SCHED;
      PG8_LDA(At, 1, 1); PG8_STAGE(PG8_SB(1, 0), b3, voffB); PG8_STAGE(PG8_SB(1, 1), b3 + hstepB, voffB); PG8_STAGE(PG8_SA(1, 0), a3, voffA);
      PG8_WAIT_V(8); PG8_WAIT_L(0); PG8_BAR; PG8_MMA(1, 0, At, B0); PG8_MMA(1, 1, At, B1); PG8_BAR; PG8_SCHED;
    }
    if (wr == 0) PG8_BAR;
    E(acc, cur, wr, wc, fr, fq);
    if (!has_next) break;
#pragma unroll
    for (int a = 0; a < 2; ++a)
#pragma unroll
      for (int b = 0; b < 2; ++b)
#pragma unroll
        for (int m = 0; m < 4; ++m)
#pragma unroll
          for (int n = 0; n < 2; ++n) acc[a][b][m][n] = (f32x4){0.f, 0.f, 0.f, 0.f};
    cur = nxt; cA = nA; cB = nB; ++ui;
    if (wr == 1) PG8_BAR;
  }
  PG8_WAIT_V(0);
  PG8_BAR;
#undef PG8_SA
#undef PG8_SB
#undef PG8_STAGE
#undef PG8_LDA
#undef PG8_LDB
#undef PG8_MMA
#undef PG8_WAIT_V
#undef PG8_WAIT_L
#undef PG8_BAR
#undef PG8_SCHED
}
}
template <int D, bool ROPE>
DI void headnorm_phase(const bf16_t* src1, int ld1, int hs1, const bf16_t* src2, int ld2, int hs2, bf16_t* dst, int ldd, int hsd,
                       const float* __restrict__ gain, int nrows, int nheads, const int* __restrict__ pos, float oscale) {
  constexpr int NM = D / 16, U = 8;
  const int tidh = launder_tid();
  const int s = tidh & 15;
  const long nitems = (long)nrows * nheads;
  const long stride = (long)gridDim.x * (NTHREADS / 16);
  float gn[NM];
#pragma unroll
  for (int m = 0; m < NM; ++m) gn[m] = gain[s + 16 * m] * oscale;
  const float invf = ROPE ? exp2f(-(float)s * (13.287712379549449f / 16.f)) : 0.f;
  for (long it0 = (long)blockIdx.x * (NTHREADS / 16) + (tidh >> 4); it0 < nitems; it0 += stride * U) {
    float v[U][NM];
    int rowv[U], hdv[U];
#pragma unroll
    for (int u = 0; u < U; ++u) {
      long it = it0 + stride * u; if (it >= nitems) it = it0;
      const int row = (int)(it / nheads), hd = (int)(it - (long)row * nheads);
      rowv[u] = row; hdv[u] = hd;
#pragma unroll
      for (int m = 0; m < NM; ++m)
        v[u][m] = (m < 4) ? bf2f(src1[(size_t)row * ld1 + hd * hs1 + s + 16 * m]) : bf2f(src2[(size_t)row * ld2 + hd * hs2 + s + 16 * (m - 4)]);
    }
#pragma unroll
    for (int u = 0; u < U; ++u) {
      float ss = 0.f;
#pragma unroll
      for (int m = 0; m < NM; ++m) ss += v[u][m] * v[u][m];
      ss += __shfl_xor(ss, 1); ss += __shfl_xor(ss, 2); ss += __shfl_xor(ss, 4); ss += __shfl_xor(ss, 8);
      const float rstd = rsqrtf(ss * (1.f / D) + EPS);
#pragma unroll
      for (int m = 0; m < NM; ++m) v[u][m] = v[u][m] * rstd * gn[m];
      if (ROPE) {
        const float ang = (float)pos[rowv[u]] * invf;
        float rev = ang * 0.15915494309189535f;
        rev = rev - floorf(rev);
        const float sn = __builtin_amdgcn_sinf(rev), cs = __builtin_amdgcn_cosf(rev);
        const float x1 = v[u][NM - 2], x2 = v[u][NM - 1];
        v[u][NM - 2] = x1 * cs - x2 * sn;
        v[u][NM - 1] = x2 * cs + x1 * sn;
      }
    }
#pragma unroll
    for (int u = 0; u < U; ++u)
#pragma unroll
      for (int m = 0; m < NM; ++m) dst[(size_t)rowv[u] * ldd + hdv[u] * hsd + s + 16 * m] = tobf(v[u][m]);
  }
}

typedef short v4i16_t __attribute__((ext_vector_type(4)));
DI s16x4 tr_read(const char* p) {
  return __builtin_bit_cast(s16x4, __builtin_amdgcn_ds_read_tr16_b64_v4i16((__attribute__((address_space(3))) v4i16_t*)p));
}
template <int DQK, int MODE, bool QN, bool KN>
DI void attn_item(const bf16_t* __restrict__ Q, int ldq, const bf16_t* __restrict__ Kp, int ldk, const bf16_t* __restrict__ Vp, int ldv,
                  int q0, int nkt, bf16_t* __restrict__ O, float scale, char* smem,
                  const float* __restrict__ gq, float oscale, const int* __restrict__ qpos, const float* __restrict__ gk) {
  constexpr int NS = DQK / 16, KROW = (DQK + 8) * 2, KBYTES = 128 * KROW, VIMG = 128 * 64, BUF = KBYTES + 2 * VIMG, NKC = DQK / 8, NKL = (128 * NKC) / NTHREADS;
  static_assert((128 * NKC) % NTHREADS == 0, "K chunks per stage must divide evenly");
  static_assert(!KN || DQK == 64, "key normalisation on load is written for 64-dim keys");
  const int tid = launder_tid(), lane = tid & 63, wave = tid >> 6, r = lane & 31, h = lane >> 5;
  const int qrow = q0 + wave * 32 + r;
  const int qwmax = q0 + wave * 32 + 31;
  bf16x8 qf[NS];
#pragma unroll
  for (int s = 0; s < NS; ++s) qf[s] = *(const bf16x8*)(Q + (size_t)(wave * 32 + r) * ldq + 16 * s + 8 * h);
  if (QN) {
    float qv[NS][8];
    float ss = 0.f;
#pragma unroll
    for (int s = 0; s < NS; ++s)
#pragma unroll
      for (int j = 0; j < 8; ++j) { qv[s][j] = bf2f((bf16_t)qf[s][j]); ss += qv[s][j] * qv[s][j]; }
    ss += __shfl_xor(ss, 32);
    const float rstd = rsqrtf(ss * (1.f / DQK) + EPS) * oscale;
#pragma unroll
    for (int s = 0; s < NS; ++s) {
      const f32x4 g0 = *(const f32x4*)(gq + 16 * s + 8 * h), g1 = *(const f32x4*)(gq + 16 * s + 8 * h + 4);
#pragma unroll
      for (int j = 0; j < 4; ++j) { qv[s][j] *= rstd * g0[j]; qv[s][4 + j] *= rstd * g1[j]; }
    }
    if (DQK == 96) {
      const float pf_ = (float)qpos[wave * 32 + r];
#pragma unroll
      for (int j = 0; j < 8; ++j) {
        const float ang = pf_ * exp2f(-(float)(8 * h + j) * (13.287712379549449f / 16.f));
        float rev = ang * 0.15915494309189535f; rev = rev - floorf(rev);
        const float sn = __builtin_amdgcn_sinf(rev), cs = __builtin_amdgcn_cosf(rev);
        const float x1 = qv[NS - 2][j], x2 = qv[NS - 1][j];
        qv[NS - 2][j] = x1 * cs - x2 * sn; qv[NS - 1][j] = x2 * cs + x1 * sn;
      }
    }
#pragma unroll
    for (int s = 0; s < NS; ++s) {
      u32x4 w; w.x = pack2(qv[s][0], qv[s][1]); w.y = pack2(qv[s][2], qv[s][3]); w.z = pack2(qv[s][4], qv[s][5]); w.w = pack2(qv[s][6], qv[s][7]);
      qf[s] = __builtin_bit_cast(bf16x8, w);
    }
  }
  f32x4 gk0 = {1.f, 1.f, 1.f, 1.f}, gk1 = {1.f, 1.f, 1.f, 1.f};
  if (KN) { gk0 = *(const f32x4*)(gk + (tid & 7) * 8); gk1 = *(const f32x4*)(gk + (tid & 7) * 8 + 4); }
  float sbound = 0.f; bool fixed_shift = false;
  if (MODE != 2 && QN) {
    float gqm = 0.f, gkm = 0.f;
#pragma unroll
    for (int s = 0; s < NS; ++s)
#pragma unroll
      for (int j = 0; j < 8; ++j) { gqm = fmaxf(gqm, fabsf(gq[16 * s + 8 * h + j])); gkm = fmaxf(gkm, fabsf(gk[16 * s + 8 * h + j])); }
    gqm = fmaxf(gqm, __shfl_xor(gqm, 32)); gkm = fmaxf(gkm, __shfl_xor(gkm, 32));
    sbound = sqrtf((float)DQK) * 1.4426950408889634f * gqm * gkm * 1.02f + 0.01f;
    fixed_shift = __builtin_amdgcn_readfirstlane(sbound < 48.f ? 1 : 0) != 0;
  }
  f32x16 o[2];
#pragma unroll
  for (int a = 0; a < 2; ++a)
#pragma unroll
    for (int i = 0; i < 16; ++i) o[a][i] = 0.f;
  float m_run = -INFINITY, l_run = 0.f, carry = 1.f;
  u32x4 rk0[NKL], rv0[2], rk1[NKL], rv1[2];
  const int vtr_off = (4 * h + ((lane & 15) >> 2)) * 64 + (((lane >> 4) & 1) * 16 + 4 * (lane & 3)) * 2;

#define AT_GLOAD(RK, RV, SG) { const int key0_ = stage_key0(SG); _Pragma("unroll") for (int i = 0; i < NKL; ++i) { const int c = tid + NTHREADS * i; const int row = c / NKC, kc = c - row * NKC; RK[i] = *(const u32x4*)(Kp + (size_t)(key0_ + row) * ldk + kc * 8); } \
    _Pragma("unroll") for (int i = 0; i < 2; ++i) { const int c = tid + NTHREADS * i; const int key = c >> 3, cc = c & 7; RV[i] = *(const u32x4*)(Vp + (size_t)(key0_ + key) * ldv + cc * 8); } }
#define AT_SWRITE(RK, RV, BUFI) { char* sK_ = smem + (BUFI) * BUF; char* sV_ = sK_ + KBYTES; _Pragma("unroll") for (int i = 0; i < NKL; ++i) { const int c = tid + NTHREADS * i; const int row = c / NKC, kc = c - row * NKC; u32x4 kw_ = RK[i]; \
      if (KN) { float kv_[8]; kv_[0] = __uint_as_float(kw_.x << 16); kv_[1] = __uint_as_float(kw_.x & 0xffff0000u); kv_[2] = __uint_as_float(kw_.y << 16); kv_[3] = __uint_as_float(kw_.y & 0xffff0000u); \
        kv_[4] = __uint_as_float(kw_.z << 16); kv_[5] = __uint_as_float(kw_.z & 0xffff0000u); kv_[6] = __uint_as_float(kw_.w << 16); kv_[7] = __uint_as_float(kw_.w & 0xffff0000u); \
        float ks_ = 0.f; _Pragma("unroll") for (int j = 0; j < 8; ++j) ks_ += kv_[j] * kv_[j]; \
        ks_ += __shfl_xor(ks_, 1); ks_ += __shfl_xor(ks_, 2); ks_ += __shfl_xor(ks_, 4); const float kr_ = rsqrtf(ks_ * (1.f / 64.f) + EPS); \
        kw_.x = pack2(kv_[0] * kr_ * gk0[0], kv_[1] * kr_ * gk0[1]); kw_.y = pack2(kv_[2] * kr_ * gk0[2], kv_[3] * kr_ * gk0[3]); \
        kw_.z = pack2(kv_[4] * kr_ * gk1[0], kv_[5] * kr_ * gk1[1]); kw_.w = pack2(kv_[6] * kr_ * gk1[2], kv_[7] * kr_ * gk1[3]); } \
      *(u32x4*)(sK_ + row * KROW + kc * 16) = kw_; } \
    _Pragma("unroll") for (int i = 0; i < 2; ++i) { const int c = tid + NTHREADS * i; const int key = c >> 3, cc = c & 7; *(u32x4*)(sV_ + (cc >> 2) * VIMG + key * 64 + (cc & 3) * 16) = RV[i]; } }
  const int nsg = nkt >> 1;
  auto tile_of = [&](int it) { return MODE == 2 ? (nkt - 1 - it) : it; };
  auto stage_key0 = [&](int sg) { const int sc = sg < nsg ? sg : nsg - 1; return 128 * (MODE == 2 ? (nsg - 1 - sc) : sc); };

  AT_GLOAD(rk0, rv0, 0)
  AT_GLOAD(rk1, rv1, 1)
  AT_SWRITE(rk0, rv0, 0)
  __syncthreads();
  auto compute = [&](int it, int bufi) {
    const int kt = tile_of(it);
    const int koff = (kt & 1) * 64;
    const char* sK = smem + bufi * BUF + koff * KROW;
    const char* sV = smem + bufi * BUF + KBYTES + koff * 64;
    bool active = (MODE == 0) || (kt * 64 <= qwmax);
    if (MODE == 2 && active) active = __builtin_amdgcn_ballot_w64(carry >= 1.17549435e-38f) != 0;
    if (active) {
      f32x16 sacc[2];
      const float sinit = fixed_shift ? -sbound : 0.f;
#pragma unroll
      for (int kb = 0; kb < 2; ++kb) {
#pragma unroll
        for (int i = 0; i < 16; ++i) sacc[kb][i] = sinit;
#pragma unroll
        for (int s = 0; s < NS; ++s) {
          const bf16x8 kf = *(const bf16x8*)(sK + (kb * 32 + r) * KROW + s * 32 + h * 16);
          sacc[kb] = MFMA32(kf, qf[s], sacc[kb]);
        }
      }
      const bool diag = (MODE != 0) && (kt * 64 + 63 >= q0 + wave * 32);
      if (MODE != 0 && diag) {
#pragma unroll
        for (int kb = 0; kb < 2; ++kb)
#pragma unroll
          for (int i = 0; i < 16; ++i) {
            const int key = kt * 64 + kb * 32 + (i & 3) + 8 * (i >> 2) + 4 * h;
            if (MODE == 1 ? (key > qrow) : (key >= qrow)) sacc[kb][i] = -INFINITY;
          }
      }
      if (MODE == 2) {
        float beta[2][16], ff[2][16];
#pragma unroll
        for (int kb = 0; kb < 2; ++kb)
#pragma unroll
          for (int i = 0; i < 16; ++i) {
            const float z = sacc[kb][i] * scale;
            const float tt = __builtin_amdgcn_exp2f(-fabsf(z) * 1.4426950408889634f);
            const float rr = __builtin_amdgcn_rcpf(1.f + tt);
            const float trr = tt * rr;
            float b = z >= 0.f ? rr : trr, f = z >= 0.f ? trr : rr;
            beta[kb][i] = b; ff[kb][i] = f;
          }
        float cp[8], cpo[8], sp[8];
#pragma unroll
        for (int m = 0; m < 8; ++m) { const int kb = m >> 2, g = m & 3; cp[m] = (ff[kb][4 * g] * ff[kb][4 * g + 1]) * (ff[kb][4 * g + 2] * ff[kb][4 * g + 3]); }
#pragma unroll
        for (int m = 0; m < 8; ++m) {
          const unsigned cu = __float_as_uint(cp[m]);
          const auto rsw = __builtin_amdgcn_permlane32_swap(cu, cu, false, false);
          cpo[m] = __uint_as_float(h == 0 ? rsw[1] : rsw[0]);
        }
        float run = carry;
#pragma unroll
        for (int m = 7; m >= 0; --m) { sp[m] = run; run *= (cp[m] * cpo[m]); }
        carry = run;
#pragma unroll
        for (int m = 0; m < 8; ++m) {
          const int kb = m >> 2, g = m & 3;
          float tq = sp[m] * (h == 0 ? cpo[m] : 1.f);
#pragma unroll
          for (int c = 3; c >= 0; --c) { sacc[kb][4 * g + c] = beta[kb][4 * g + c] * tq; tq *= ff[kb][4 * g + c]; }
        }
      } else if (fixed_shift) {
        float ps = 0.f;
#pragma unroll
        for (int kb = 0; kb < 2; ++kb)
#pragma unroll
          for (int i = 0; i < 16; ++i) { const float pv = __builtin_amdgcn_exp2f(sacc[kb][i]); sacc[kb][i] = pv; ps += pv; }
        l_run += ps;
      } else {
        float tmax = -INFINITY;
#pragma unroll
        for (int kb = 0; kb < 2; ++kb)
#pragma unroll
          for (int i = 0; i < 16; ++i) {
            tmax = fmaxf(tmax, sacc[kb][i]);
          }
        tmax = fmaxf(tmax, __shfl_xor(tmax, 32));
        const float m_new = fmaxf(m_run, tmax);
        const float alpha = __builtin_amdgcn_exp2f(m_run - m_new);
        m_run = m_new;
        float ps = 0.f;
#pragma unroll
        for (int kb = 0; kb < 2; ++kb)
#pragma unroll
          for (int i = 0; i < 16; ++i) { const float pv = __builtin_amdgcn_exp2f(sacc[kb][i] - m_new); sacc[kb][i] = pv; ps += pv; }
        l_run = l_run * alpha + ps;
        if (__builtin_amdgcn_ballot_w64(alpha != 1.f) != 0) {
#pragma unroll
          for (int a = 0; a < 2; ++a)
#pragma unroll
            for (int i = 0; i < 16; ++i) o[a][i] *= alpha;
        }
      }
#pragma unroll
      for (int kb = 0; kb < 2; ++kb)
#pragma unroll
        for (int s2 = 0; s2 < 2; ++s2) {
          u32x4 pw;
          pw.x = pack2(sacc[kb][8 * s2 + 0], sacc[kb][8 * s2 + 1]); pw.y = pack2(sacc[kb][8 * s2 + 2], sacc[kb][8 * s2 + 3]);
          pw.z = pack2(sacc[kb][8 * s2 + 4], sacc[kb][8 * s2 + 5]); pw.w = pack2(sacc[kb][8 * s2 + 6], sacc[kb][8 * s2 + 7]);
          const bf16x8 pf = __builtin_bit_cast(bf16x8, pw);
#pragma unroll
          for (int dvb = 0; dvb < 2; ++dvb) {
            const char* vb = sV + dvb * VIMG + (kb * 32 + 16 * s2) * 64 + vtr_off;
            const s16x4 v0 = tr_read(vb), v1 = tr_read(vb + 8 * 64);
            const bf16x8 vf = __builtin_shufflevector(v0, v1, 0, 1, 2, 3, 4, 5, 6, 7);
            o[dvb] = MFMA32(vf, pf, o[dvb]);
          }
        }
    }
  };
#define AT_SB __builtin_amdgcn_sched_barrier(0);
  for (int sg = 0; sg < nsg; sg += 2) {
    AT_SB AT_GLOAD(rk0, rv0, sg + 2)
    AT_SB compute(2 * sg, 0); compute(2 * sg + 1, 0); AT_SB
    AT_SWRITE(rk1, rv1, 1)
    if (MODE == 2) { if (__syncthreads_and(carry < 1.17549435e-38f)) break; } else { __syncthreads(); }
    AT_SB AT_GLOAD(rk1, rv1, sg + 3)
    AT_SB compute(2 * sg + 2, 1); compute(2 * sg + 3, 1); AT_SB
    AT_SWRITE(rk0, rv0, 0)
    if (MODE == 2) { if (__syncthreads_and(carry < 1.17549435e-38f)) break; } else { __syncthreads(); }
  }
#undef AT_SB
  float inv = 1.f;
  if (MODE != 2) { const float lt = l_run + __shfl_xor(l_run, 32); inv = 1.f / lt; }
#pragma unroll
  for (int dvb = 0; dvb < 2; ++dvb)
#pragma unroll
    for (int g = 0; g < 4; ++g) {
      u32x2 w;
      w.x = pack2(o[dvb][4 * g] * inv, o[dvb][4 * g + 1] * inv); w.y = pack2(o[dvb][4 * g + 2] * inv, o[dvb][4 * g + 3] * inv);
      *(u32x2*)(O + (size_t)(wave * 32 + r) * DM + dvb * 32 + 8 * g + 4 * h) = w;
    }
  __syncthreads();
}

template <int LAYER>
DI void attn_phase(const Params& p, char* smem) {
  char* ws = p.ws;
  bf16_t* mix = (bf16_t*)(ws + O_MIX);
  const int xcd = (int)(blockIdx.x & 7), lb = (int)(blockIdx.x >> 3), L = (int)(gridDim.x >> 3);
  for (int j = lb; j < 192 + 64; j += L) {
    if (j < 192) {
      const int hl = j >> 4, qi = j & 15, qt = ((j / L) & 1) ? (15 - qi) : qi, bh = hl * 8 + xcd, b = bh / 12, hd = bh % 12, q0 = qt * 256;
      const size_t tok0 = (size_t)b * SEQ;
      bf16_t* O = mix + (tok0 + q0) * DM + hd * 64;
      if (LAYER == 0) {
        const bf16_t* P = (const bf16_t*)(ws + O_P);
        attn_item<64, 2, false, false>(P + (tok0 + q0) * 2560 + hd * 64, 2560, P + tok0 * 2560 + 768 + hd * 64, 2560, P + tok0 * 2560 + 1536 + hd * 64, 2560,
                                       q0, q0 / 64 + 4, O, 0.125f, smem, nullptr, 1.f, nullptr, nullptr);
      } else {
        const bf16_t* Qb = (const bf16_t*)(ws + O_QB);
        const bf16_t* Kn = (const bf16_t*)(ws + O_KN);
        const bf16_t* V1 = (const bf16_t*)(ws + O_V1);
        attn_item<96, 1, true, false>(Qb + (tok0 + q0) * 1152 + hd * 96, 1152, Kn + tok0 * 1152 + hd * 96, 1152, V1 + tok0 * 768 + hd * 64, 768,
                                      q0, q0 / 64 + 4, O, 1.f, smem, p.mla_g_qn, 0.14724138410008716f, p.pos + tok0 + q0, p.mla_g_kn);
      }
    } else {
      const int j2 = j - 192, qt = j2 & 15, hm = j2 >> 4, b = xcd, q0 = qt * 256;
      const size_t tok0 = (size_t)b * SEQ;
      bf16_t* O = mix + (tok0 + q0) * DM + 768 + hm * 64;
      const bf16_t* KR = (const bf16_t*)(ws + O_KMRAW) + (size_t)LAYER * 2048 * 512 + (size_t)(b * 256) * 512 + hm * 128;
      const bf16_t* Qm = LAYER == 0 ? (const bf16_t*)(ws + O_P) + (tok0 + q0) * 2560 + 2304 + hm * 64 : (const bf16_t*)(ws + O_PM) + (tok0 + q0) * 1408 + 1056 + hm * 64;
      attn_item<64, 0, true, true>(Qm, LAYER == 0 ? 2560 : 1408, KR, 512, KR + 64, 512, q0, 4, O, 1.f, smem,
                                   p.g_qn_mem + LAYER * 64, 0.18033688011112042f, nullptr, p.g_kn_mem + LAYER * 64);
    }
  }
}

__global__ void __launch_bounds__(NTHREADS, 2) fwd_megakernel(Params p) {
  extern __shared__ __attribute__((aligned(16))) char smem[];
  cg::grid_group grid = cg::this_grid();
  char* ws = p.ws;
  int toff = 0;
  __shared__ uint4 xb_words;
  if (threadIdx.x == 0) xb_words = make_uint4(0u, 0u, 0u, 0u);
  __syncthreads();
  const XcdBarrier xb = xcd_barrier_post((unsigned*)(ws + O_BAR), (volatile LAS unsigned*)&xb_words);
  PG8_LAS unsigned char* lds = (PG8_LAS unsigned char*)smem;
  float* ps1 = (float*)(ws + O_PS1); float* ps2 = (float*)(ws + O_PS2);
  transpose_job<true>(p.sb_w_in, p.ln_attn, (bf16_t*)(ws + O_SBIN), 1024, 2560, 2560, 0, smem, toff);
  transpose_job<false>(p.w_out, nullptr, (bf16_t*)(ws + O_OUT0), 1024, 1024, 1024, 0, smem, toff);
  transpose_job<false>(p.w_out + (size_t)1024 * 1024, nullptr, (bf16_t*)(ws + O_OUT1), 1024, 1024, 1024, 0, smem, toff);
  transpose_job<true>(p.w_mem_kv, p.ln_mem, (bf16_t*)(ws + O_MKV0), 1024, 512, 512, 0, smem, toff);
  transpose_job<true>(p.w_mem_kv + (size_t)1024 * 512, p.ln_mem + 1024, (bf16_t*)(ws + O_MKV1), 1024, 512, 512, 0, smem, toff);
  transpose_job<true>(p.w_ffn_gu, p.ln_ffn, (bf16_t*)(ws + O_GU0), 1024, 5632, 5632, 1, smem, toff);
  transpose_job<true>(p.w_ffn_gu + (size_t)1024 * 5632, p.ln_ffn + 1024, (bf16_t*)(ws + O_GU1), 1024, 5632, 5632, 1, smem, toff);
  transpose_job<false>(p.w_ffn_down, nullptr, (bf16_t*)(ws + O_DN0), 2816, 1024, 1024, 0, smem, toff);
  transpose_job<false>(p.w_ffn_down + (size_t)2816 * 1024, nullptr, (bf16_t*)(ws + O_DN1), 2816, 1024, 1024, 0, smem, toff);
  transpose_job<true>(p.mla_w_in, p.ln_attn + 1024, (bf16_t*)(ws + O_MLAIN), 1024, 1312, 1536, 0, smem, toff);
  transpose_job<true>(p.mla_w_q_up, p.mla_q_norm, (bf16_t*)(ws + O_QUP), 768, 1152, 1280, 0, smem, toff);
  transpose_job<true>(p.mla_w_kv_up, p.mla_kv_norm, (bf16_t*)(ws + O_KVUP), 256, 1536, 1536, 0, smem, toff);
  convert_rows(p.x, (bf16_t*)(ws + O_XB), T_TOK, false, ps1);
  convert_rows(p.mem, (bf16_t*)(ws + O_MEMN), 2048, true, nullptr);
  if (p.ws == nullptr) grid.sync();
  xcd_barrier(xb);
  toff = 0;
  {
    pg8::Gemm g{(const bf16_t*)(ws + O_XB), 1024, (const bf16_t*)(ws + O_SBIN), T_TOK, 2560, 1024};
    pg8::XOrder S; S.init(T_TOK, 2560, toff);
    pg8::EpiNorm<pg8::EM_PLAIN> E{(bf16_t*)(ws + O_P), 2560, 2560, nullptr, ps1, 0, 16, 1.f / 1024.f, nullptr};
    pg8::gemm_phase(lds, g, S, E);
    for (int l = 0; l < 2; ++l) {
      pg8::Gemm gm{(const bf16_t*)(ws + O_MEMN), 1024, (const bf16_t*)(ws + (l ? O_MKV1 : O_MKV0)), 2048, 512, 1024};
      pg8::XOrder Sm; Sm.init(2048, 512, toff);
      pg8::EpiNorm<pg8::EM_PLAIN> Em{(bf16_t*)(ws + O_KMRAW) + (size_t)l * 2048 * 512, 512, 512, nullptr, nullptr, 0, 0, 0.f, nullptr};
      pg8::gemm_phase(lds, gm, Sm, Em);
    }
  }
  xcd_barrier(xb);
  attn_phase<0>(p, smem);
  xcd_barrier(xb);
  toff = 0;
  {
    pg8::Gemm g{(const bf16_t*)(ws + O_MIX), 1024, (const bf16_t*)(ws + O_OUT0), T_TOK, 1024, 1024};
    pg8::XOrder S; S.init(T_TOK, 1024, toff);
    pg8::EpiResid<true, false> E{p.x, (bf16_t*)(ws + O_XB), nullptr, ps1};
    pg8::gemm_phase(lds, g, S, E);
  }
  xcd_barrier(xb);
  toff = 0;
  {
    pg8::Gemm g{(const bf16_t*)(ws + O_XB), 1024, (const bf16_t*)(ws + O_GU0), T_TOK, 5632, 1024};
    pg8::XOrder S; S.init(T_TOK, 5632, toff);
    pg8::EpiSwiglu E{(bf16_t*)(ws + O_ACT), ps1};
    pg8::gemm_phase(lds, g, S, E);
  }
  xcd_barrier(xb);
  toff = 0;
  {
    pg8::Gemm g{(const bf16_t*)(ws + O_ACT), 2816, (const bf16_t*)(ws + O_DN0), T_TOK, 1024, 2816};
    pg8::XOrder S; S.init(T_TOK, 1024, toff);
    pg8::EpiResid<false, false> E{nullptr, (bf16_t*)(ws + O_XB), nullptr, ps1};
    pg8::gemm_phase(lds, g, S, E);
  }
  xcd_barrier(xb);
  toff = 0;
  {
    pg8::Gemm g{(const bf16_t*)(ws + O_XB), 1024, (const bf16_t*)(ws + O_MLAIN), T_TOK, 1536, 1024};
    pg8::XOrder S; S.init(T_TOK, 1536, toff);
    pg8::EpiNorm<pg8::EM_PLAIN, true> E{(bf16_t*)(ws + O_PM), 1408, 1408, nullptr, ps1, 0, 16, 1.f / 1024.f, ps2};
    pg8::gemm_phase(lds, g, S, E);
  }
  xcd_barrier(xb);
  toff = 0;
  {
    pg8::Gemm g{(const bf16_t*)(ws + O_PM), 1408, (const bf16_t*)(ws + O_QUP), T_TOK, 1280, 768};
    pg8::XOrder S; S.init(T_TOK, 1280, toff);
    pg8::EpiNorm<pg8::EM_PLAIN> E{(bf16_t*)(ws + O_QB), 1152, 1152, nullptr, ps2, 0, 12, 1.f / 768.f, nullptr};
    pg8::gemm_phase(lds, g, S, E);
    pg8::Gemm g2{(const bf16_t*)(ws + O_PM) + 768, 1408, (const bf16_t*)(ws + O_KVUP), T_TOK, 1536, 256};
    pg8::XOrder S2; S2.init(T_TOK, 1536, toff);
    pg8::EpiNorm<pg8::EM_KVUP> E2{(bf16_t*)(ws + O_KN), 1152, 1536, (bf16_t*)(ws + O_V1), ps2, 12, 16, 1.f / 256.f, nullptr};
    pg8::gemm_phase(lds, g2, S2, E2);
  }
  xcd_barrier(xb);
  {
    bf16_t* kn = (bf16_t*)(ws + O_KN); bf16_t* pm = (bf16_t*)(ws + O_PM);
    headnorm_phase<96, true>(kn, 1152, 96, pm + 1024, 1408, 0, kn, 1152, 96, p.mla_g_kn, T_TOK, 12, p.pos, 1.f);
  }
  xcd_barrier(xb);
  attn_phase<1>(p, smem);
  xcd_barrier(xb);
  toff = 0;
  {
    pg8::Gemm g{(const bf16_t*)(ws + O_MIX), 1024, (const bf16_t*)(ws + O_OUT1), T_TOK, 1024, 1024};
    pg8::XOrder S; S.init(T_TOK, 1024, toff);
    pg8::EpiResid<false, false> E{nullptr, (bf16_t*)(ws + O_XB), nullptr, ps1};
    pg8::gemm_phase(lds, g, S, E);
  }
  xcd_barrier(xb);
  toff = 0;
  {
    pg8::Gemm g{(const bf16_t*)(ws + O_XB), 1024, (const bf16_t*)(ws + O_GU1), T_TOK, 5632, 1024};
    pg8::XOrder S; S.init(T_TOK, 5632, toff);
    pg8::EpiSwiglu E{(bf16_t*)(ws + O_ACT), ps1};
    pg8::gemm_phase(lds, g, S, E);
  }
  xcd_barrier(xb);
  toff = 0;
  {
    pg8::Gemm g{(const bf16_t*)(ws + O_ACT), 2816, (const bf16_t*)(ws + O_DN1), T_TOK, 1024, 2816};
    pg8::XOrder S; S.init(T_TOK, 1024, toff);
    pg8::EpiResid<false, true> E{nullptr, (bf16_t*)(ws + O_XB), p.out, nullptr};
    pg8::gemm_phase(lds, g, S, E);
  }
}

extern "C" void kernel_launch(void* const* d_in, const int* in_sizes, int n_in, void* d_out, int out_size, void* d_ws, size_t ws_size,
                              hipStream_t stream) {
  static int grid_blocks = 0;
  if (!grid_blocks) {
    (void)hipFuncSetAttribute((const void*)fwd_megakernel, hipFuncAttributeMaxDynamicSharedMemorySize, LDS_BYTES);
    int dev = 0, cus = 0, per_cu = 0;
    (void)hipGetDevice(&dev);
    (void)hipDeviceGetAttribute(&cus, hipDeviceAttributeMultiprocessorCount, dev);
    (void)hipOccupancyMaxActiveBlocksPerMultiprocessor(&per_cu, fwd_megakernel, NTHREADS, LDS_BYTES);
    if (per_cu > 1) per_cu = 1;
    if (per_cu < 1) per_cu = 1;
    grid_blocks = cus * per_cu;
  }
  Params p;
  std::memset((void*)&p, 0, sizeof(p));
  p.x = (const float*)d_in[0]; p.mem = (const float*)d_in[1]; p.pos = (const int*)d_in[2];
  p.ln_attn = (const float*)d_in[3]; p.w_out = (const float*)d_in[4]; p.ln_mem = (const float*)d_in[5]; p.w_mem_kv = (const float*)d_in[6];
  p.g_qn_mem = (const float*)d_in[7]; p.g_kn_mem = (const float*)d_in[8]; p.ln_ffn = (const float*)d_in[9]; p.w_ffn_gu = (const float*)d_in[10];
  p.w_ffn_down = (const float*)d_in[11]; p.sb_w_in = (const float*)d_in[12]; p.mla_w_in = (const float*)d_in[13]; p.mla_q_norm = (const float*)d_in[14];
  p.mla_w_q_up = (const float*)d_in[15]; p.mla_kv_norm = (const float*)d_in[16]; p.mla_w_kv_up = (const float*)d_in[17];
  p.mla_g_qn = (const float*)d_in[18]; p.mla_g_kn = (const float*)d_in[19];
  p.out = (float*)d_out; p.ws = (char*)d_ws;
  (void)hipMemsetAsync((char*)d_ws + O_BAR, 0, XCD_BAR_WORDS * sizeof(unsigned), stream);
  void* args[] = {&p};
  hipError_t e = hipLaunchCooperativeKernel((const void*)fwd_megakernel, dim3(grid_blocks), dim3(NTHREADS), args, LDS_BYTES, stream);
  if (e != hipSuccess) fprintf(stderr, "cooperative launch failed: %s (grid %d)\n", hipGetErrorString(e), grid_blocks);
}
```

```cpp
#include <hip/hip_runtime.h>
#include <hip/hip_cooperative_groups.h>
#include <cstdint>
#include <cstdio>
#include <cmath>
#include <cstring>
namespace cg = cooperative_groups;

#define DI __device__ __forceinline__
typedef unsigned short bf16_t;
typedef short bf16x8 __attribute__((ext_vector_type(8)));
typedef short s16x4 __attribute__((ext_vector_type(4)));
typedef float f32x16 __attribute__((ext_vector_type(16)));
typedef float f32x4 __attribute__((ext_vector_type(4)));
typedef float f32x2 __attribute__((ext_vector_type(2)));
typedef unsigned u32x4 __attribute__((ext_vector_type(4)));
typedef unsigned u32x2 __attribute__((ext_vector_type(2)));
typedef __bf16 bf2_t __attribute__((ext_vector_type(2)));

constexpr int T_TOK = 32768, SEQ = 4096, NBATCH = 8, DM = 1024, DFF = 2816, NMEM = 256;
constexpr int NTHREADS = 512;
constexpr int LDS_BYTES = 131072 + 4096;
constexpr float EPS = 1e-6f;

constexpr size_t SZ_SBIN = (size_t)2560 * 1024 * 2, SZ_OUT = (size_t)1024 * 1024 * 2, SZ_MKV = (size_t)512 * 1024 * 2,
                 SZ_GU = (size_t)5632 * 1024 * 2, SZ_DN = (size_t)1024 * 2816 * 2, SZ_MLAIN = (size_t)1536 * 1024 * 2,
                 SZ_QUP = (size_t)1280 * 768 * 2, SZ_KVUP = (size_t)1536 * 256 * 2;
constexpr size_t O_SBIN = 0, O_OUT0 = O_SBIN + SZ_SBIN, O_OUT1 = O_OUT0 + SZ_OUT, O_MKV0 = O_OUT1 + SZ_OUT, O_MKV1 = O_MKV0 + SZ_MKV,
                 O_GU0 = O_MKV1 + SZ_MKV, O_GU1 = O_GU0 + SZ_GU, O_DN0 = O_GU1 + SZ_GU, O_DN1 = O_DN0 + SZ_DN, O_MLAIN = O_DN1 + SZ_DN,
                 O_QUP = O_MLAIN + SZ_MLAIN, O_KVUP = O_QUP + SZ_QUP, O_XB = O_KVUP + SZ_KVUP;
constexpr size_t SZ_XB = (size_t)T_TOK * 1024 * 2;
constexpr size_t O_MIX = O_XB + SZ_XB, O_MEMN = O_MIX + SZ_XB, O_KMRAW = O_MEMN + (size_t)2048 * 1024 * 2,
                 O_KM = O_KMRAW + (size_t)2 * 2048 * 512 * 2, O_PS1 = O_KM + (size_t)2 * 2048 * 256 * 2,
                 O_PS2 = O_PS1 + (size_t)T_TOK * 16 * 4, O_BAR = O_PS2 + (size_t)T_TOK * 16 * 4, O_ARENA = O_BAR + 16384;
constexpr size_t O_P = O_ARENA;
constexpr size_t O_PM = O_ARENA, O_QB = O_PM + (size_t)T_TOK * 1408 * 2, O_KN = O_QB + (size_t)T_TOK * 1152 * 2,
                 O_V1 = O_KN + (size_t)T_TOK * 1152 * 2, O_END = O_V1 + (size_t)T_TOK * 768 * 2;
constexpr size_t O_ACT = O_ARENA;
static_assert(O_END <= (size_t)512 * 1024 * 1024, "workspace map exceeds 512 MiB");

struct Params {
  const float *x, *mem; const int* pos;
  const float *ln_attn, *w_out, *ln_mem, *w_mem_kv, *g_qn_mem, *g_kn_mem, *ln_ffn, *w_ffn_gu, *w_ffn_down, *sb_w_in, *mla_w_in,
      *mla_q_norm, *mla_w_q_up, *mla_kv_norm, *mla_w_kv_up, *mla_g_qn, *mla_g_kn;
  float* out; char* ws;
};

DI int launder_tid() { int t = threadIdx.x; asm volatile("" : "+v"(t)); return t; }
DI unsigned pack2(float a, float b) { bf2_t v = __builtin_convertvector((f32x2){a, b}, bf2_t); return __builtin_bit_cast(unsigned, v); }
DI bf16_t tobf(float a) { return (bf16_t)(pack2(a, 0.f) & 0xffffu); }
DI float bf2f(bf16_t v) { return __uint_as_float(((unsigned)v) << 16); }
#define MFMA32(a, b, c) __builtin_amdgcn_mfma_f32_32x32x16_bf16((a), (b), (c), 0, 0, 0)
#define XB_TMO      128
#define XB_XCNT(j)  (256  + 64 * (j))
#define XB_XSUB(j)  (1280 + 64 * (j))
#define XB_XGEN(j)  (2304 + 64 * (j))
#define XB_TOP      3328
#define XB_TOPGEN   3392
#define XCD_BAR_WORDS 3456
#define XB_SPIN_CAP (1u << 20)
#define LAS __attribute__((address_space(3)))
DI unsigned xb_ld(unsigned* p) { return __hip_atomic_load(p, __ATOMIC_RELAXED, __HIP_MEMORY_SCOPE_AGENT); }
DI unsigned xb_add(unsigned* p, unsigned v) { return __hip_atomic_fetch_add(p, v, __ATOMIC_RELAXED, __HIP_MEMORY_SCOPE_AGENT); }
DI unsigned xb_xcc_id() { return (unsigned)__builtin_amdgcn_s_getreg((3 << 11) | 20) & 0xFu; }
#define XB_SPIN(cond, bar) do { unsigned _sp = 0; while (cond) { __builtin_amdgcn_s_sleep(1); \
    if ((++_sp & 255u) == 0u) { if (xb_ld(&(bar)[XB_TMO])) break; if (_sp > XB_SPIN_CAP) { atomicAdd(&(bar)[XB_TMO], 1u); break; } } } } while (0)
struct XcdBarrier { unsigned* bar; unsigned x; volatile LAS unsigned* st; };
DI XcdBarrier xcd_barrier_post(unsigned* bar, volatile LAS unsigned* st) {
  XcdBarrier b; b.bar = bar; b.x = xb_xcc_id(); b.st = st;
  if (threadIdx.x == 0) (void)xb_add(&bar[XB_XCNT(b.x)], 1u);
  return b;
}
DI void xcd_barrier_complete(unsigned* bar, unsigned x, unsigned& nloc, unsigned& nx) {
  const unsigned G = gridDim.x * gridDim.y * gridDim.z;
  unsigned sum, cnt, mine, sp = 0u;
  for (;;) {
    sum = 0u; cnt = 0u; mine = 0u;
#pragma unroll
    for (unsigned j = 0; j < 16; ++j) { const unsigned c = xb_ld(&bar[XB_XCNT(j)]); sum += c; cnt += (c > 0u) ? 1u : 0u; mine = (j == x) ? c : mine; }
    if (sum == G) break;
    __builtin_amdgcn_s_sleep(1);
    if ((++sp & 255u) == 0u) { if (xb_ld(&bar[XB_TMO])) break; if (sp > XB_SPIN_CAP) { atomicAdd(&bar[XB_TMO], 1u); break; } }
  }
  nloc = mine > 0u ? mine : 1u; nx = cnt > 0u ? cnt : 1u;
}
DI void xcd_barrier(const XcdBarrier& b) {
  asm volatile("s_waitcnt vmcnt(0)" ::: "memory");
  __syncthreads();
  if (threadIdx.x == 0) {
    unsigned* bar = b.bar;
    __builtin_amdgcn_s_waitcnt(0);
    unsigned nloc = b.st[0], nx = b.st[1];
    if (nloc == 0u) { xcd_barrier_complete(bar, b.x, nloc, nx); b.st[0] = nloc; b.st[1] = nx; }
    const unsigned old = xb_add(&bar[XB_XSUB(b.x)], 1u);
    const unsigned gen = old / nloc;
    if (old + 1u == (gen + 1u) * nloc) {
      __builtin_amdgcn_fence(__ATOMIC_RELEASE, "agent");
      asm volatile("s_waitcnt vmcnt(0)" ::: "memory");
      const unsigned og = xb_add(&bar[XB_TOP], 1u);
      const unsigned tg = og / nx;
      if (og + 1u == (tg + 1u) * nx) xb_add(&bar[XB_TOPGEN], 1u);
      else XB_SPIN(xb_ld(&bar[XB_TOPGEN]) == tg, bar);
      __builtin_amdgcn_fence(__ATOMIC_ACQUIRE, "agent");
      xb_add(&bar[XB_XGEN(b.x)], 1u);
      asm volatile("s_waitcnt vmcnt(0)" ::: "memory");
    } else {
      XB_SPIN(xb_ld(&bar[XB_XGEN(b.x)]) == gen, bar);
      __builtin_amdgcn_fence(__ATOMIC_ACQUIRE, "agent");
      asm volatile("s_waitcnt vmcnt(0)" ::: "memory");
    }
  }
  __syncthreads();
}


template <bool HASG>
DI void transpose_job(const float* __restrict__ W, const float* __restrict__ g, bf16_t* __restrict__ Bt, int K, int N, int Npad, int perm,
                      char* smem, int& toff) {
  const int nk = K >> 6, nn = Npad >> 6, ntiles = nk * nn, G = gridDim.x, tid = launder_tid();
  const int nl = tid & 63, kq = tid >> 6;
  int start = (int)((blockIdx.x + G - (toff % G)) % G);
  for (int t = start; t < ntiles; t += 2 * G) {
    float v[2][8];
    bool okv[2]; int n0v[2], k0v[2];
#pragma unroll
    for (int u = 0; u < 2; ++u) {
      int tt = t + u * G; if (tt >= ntiles) tt = t;
      const int ntile = tt / nk, kt = tt - ntile * nk, n0 = ntile * 64, k0 = kt * 64;
      n0v[u] = n0; k0v[u] = k0;
      const int n = n0 + nl;
      int src = n;
      if (perm) src = (((n >> 7) & 1) ? DFF : 0) + (n >> 8) * 128 + (n & 127);
      okv[u] = n < N;
      if (!okv[u]) src = N - 1;
      const float* wp = W + (size_t)(k0 + kq) * N + src;
#pragma unroll
      for (int i = 0; i < 8; ++i) v[u][i] = wp[(size_t)(8 * i) * N];
    }
#pragma unroll
    for (int u = 0; u < 2; ++u) {
      bf16_t* sm = (bf16_t*)smem + u * (64 * 72);
      if (HASG) {
#pragma unroll
        for (int i = 0; i < 8; ++i) v[u][i] *= g[k0v[u] + kq + 8 * i];
      }
#pragma unroll
      for (int i = 0; i < 8; ++i) sm[nl * 72 + kq + 8 * i] = tobf(okv[u] ? v[u][i] : 0.f);
    }
    __syncthreads();
#pragma unroll
    for (int u = 0; u < 2; ++u) {
      const bf16_t* sm = (const bf16_t*)smem + u * (64 * 72);
      const int row = tid >> 3, kc = tid & 7;
      u32x4 vv = *(const u32x4*)(sm + row * 72 + kc * 8);
      *(u32x4*)(Bt + (size_t)(n0v[u] + row) * K + k0v[u] + kc * 8) = vv;
    }
    __syncthreads();
  }
  toff += ntiles;
}

DI void convert_rows(const float* __restrict__ X, bf16_t* __restrict__ XB, int rows, bool norm, float* __restrict__ ps) {
  const int tidc = launder_tid();
  const int lane = tidc & 63, wave = tidc >> 6;
  const int stride = gridDim.x * 8;
  for (int row0 = blockIdx.x * 8 + wave; row0 < rows; row0 += 2 * stride) {
    f32x4 v[2][4];
    int rw[2];
#pragma unroll
    for (int u = 0; u < 2; ++u) {
      int row = row0 + u * stride; if (row >= rows) row = row0;
      rw[u] = row;
      const float* xr = X + (size_t)row * DM;
#pragma unroll
      for (int i = 0; i < 4; ++i) v[u][i] = *(const f32x4*)(xr + i * 256 + lane * 4);
    }
#pragma unroll
    for (int u = 0; u < 2; ++u) {
      float ss = 0.f;
#pragma unroll
      for (int i = 0; i < 4; ++i) ss += v[u][i][0] * v[u][i][0] + v[u][i][1] * v[u][i][1] + v[u][i][2] * v[u][i][2] + v[u][i][3] * v[u][i][3];
#pragma unroll
      for (int o = 32; o >= 1; o >>= 1) ss += __shfl_xor(ss, o);
      float sc = 1.f;
      if (norm) sc = rsqrtf(ss * (1.f / DM) + EPS);
      if (ps && lane < 16) ps[(size_t)rw[u] * 16 + lane] = lane == 0 ? ss : 0.f;
#pragma unroll
      for (int i = 0; i < 4; ++i) {
        u32x2 w; w.x = pack2(v[u][i][0] * sc, v[u][i][1] * sc); w.y = pack2(v[u][i][2] * sc, v[u][i][3] * sc);
        *(u32x2*)(XB + (size_t)rw[u] * DM + i * 256 + lane * 4) = w;
      }
    }
  }
}

namespace pg8 {
#define PG8_LAS __attribute__((address_space(3)))
constexpr int BM = 256, BK = 64, HALF = 128, HTB = HALF * BK * 2, STAGE_BYTES = 8 * HTB;
DI int lds_byte(int r, int c) { const int st = (r >> 4) * 2 + (c >> 5), rr = r & 15, cc = c & 31, ob = rr * 64 + cc * 2; return st * 1024 + (ob ^ (((ob >> 9) & 1) << 5)); }
DI void stage_rc(int b, int& R, int& C) { const int st = b / 1024, sb = b % 1024, swz = sb ^ (((sb >> 9) & 1) << 5); R = (st >> 1) * 16 + swz / 64; C = (st & 1) * 32 + (swz % 64) / 2; }
DI int perm32(int rho) { const int n = rho >> 4, i = rho & 15; return 8 * (i >> 2) + 4 * n + (i & 3); }
struct Unit { int pm, pn; };
struct Gemm { const bf16_t* A; int lda; const bf16_t* Bt; int M, N, K; };

struct XOrder {
  int nN, G, xcd, mper, gms, ntl, rot, skew, lbv;
  DI void init(int M, int N, int& toff, int skew_ = 0) {
    skew = skew_; lbv = (int)(blockIdx.x >> 3);
    const int nM = M / BM; nN = N / BM; G = (int)(gridDim.x >> 3); xcd = (int)(blockIdx.x & 7); const int lb = (int)(blockIdx.x >> 3);
    mper = nM >> 3; gms = mper < 4 ? mper : 4; ntl = mper * nN; rot = (lb + G - (toff % G)) % G; toff += ntl;
  }
  DI bool next(int i, Unit& u) const {
    int j = rot + i * G;
    if (skew) {
      if (lbv >= 16) { if (i >= 4) return false; j = (lbv - 16) + 16 * i; } else { if (i >= 2) return false; j = 64 + lbv + 16 * i; }
    }
    if (j >= ntl) return false;
    const int mg = j / (gms * nN), rem = j - mg * (gms * nN); u.pn = rem / gms; u.pm = xcd * mper + mg * gms + (rem - u.pn * gms); return true;
  }
};

DI void rows_rstd(float (&rs)[2][4], const float* ps, const Unit& u, int wr, int fr, int fq, int p_lo, int p_hi, float inv_dim) {
  f32x4 pv[2][4];
#pragma unroll
  for (int ai = 0; ai < 2; ++ai)
#pragma unroll
    for (int m = 0; m < 4; ++m) pv[ai][m] = *(const f32x4*)(ps + (size_t)(u.pm * BM + ai * HALF + wr * 64 + m * 16 + fr) * 16 + 4 * fq);
  const bool use = (4 * fq >= p_lo) && (4 * fq < p_hi);
#pragma unroll
  for (int ai = 0; ai < 2; ++ai)
#pragma unroll
    for (int m = 0; m < 4; ++m) {
      float s = use ? (pv[ai][m][0] + pv[ai][m][1]) + (pv[ai][m][2] + pv[ai][m][3]) : 0.f;
      s += __shfl_xor(s, 16); s += __shfl_xor(s, 32);
      rs[ai][m] = rsqrtf(s * inv_dim + EPS);
    }
}
enum { EM_PLAIN = 0, EM_KVUP = 1 };
template <int EMODE, bool PSOUT = false> struct EpiNorm {
  static constexpr bool PERM = true, AFTER_DRAIN = false;
  bf16_t* O; int ldo; int ncols; bf16_t* O2; const float* ps_in; int p_lo, p_hi; float inv_dim; float* ps_out;
  DI void operator()(const f32x4 (&acc)[2][2][4][2], const Unit& u, int wr, int wc, int fr, int fq) const {
    float rsv[2][4];
    if (ps_in) rows_rstd(rsv, ps_in, u, wr, fr, fq, p_lo, p_hi, inv_dim);
#pragma unroll
    for (int ai = 0; ai < 2; ++ai)
#pragma unroll
      for (int m = 0; m < 4; ++m) {
        const int row = u.pm * BM + ai * HALF + wr * 64 + m * 16 + fr;
        const float rs = ps_in ? rsv[ai][m] : 1.f;
        float ssum = 0.f;
#pragma unroll
        for (int bj = 0; bj < 2; ++bj) {
          const int c0 = u.pn * BM + bj * HALF + wc * 32 + 8 * fq;
          const f32x4 v0 = acc[ai][bj][m][0] * rs, v1 = acc[ai][bj][m][1] * rs;
          if (PSOUT) ssum += (v0[0] * v0[0] + v0[1] * v0[1]) + (v0[2] * v0[2] + v0[3] * v0[3]) + (v1[0] * v1[0] + v1[1] * v1[1]) + (v1[2] * v1[2] + v1[3] * v1[3]);
          u32x4 w; w.x = pack2(v0[0], v0[1]); w.y = pack2(v0[2], v0[3]); w.z = pack2(v1[0], v1[1]); w.w = pack2(v1[2], v1[3]);
          if (EMODE == EM_KVUP) {
            const int hh = c0 >> 7, j = c0 & 127;
            if (j < 64) *(u32x4*)(O + (size_t)row * 1152 + hh * 96 + j) = w; else *(u32x4*)(O2 + (size_t)row * 768 + hh * 64 + (j - 64)) = w;
          } else {
            if (c0 < ncols) *(u32x4*)(O + (size_t)row * ldo + c0) = w;
          }
        }
        if (PSOUT) { ssum += __shfl_xor(ssum, 16); ssum += __shfl_xor(ssum, 32); if (fq == 0 && u.pn < 4) ps_out[(size_t)row * 16 + u.pn * 4 + wc] = ssum; }
      }
  }
};
struct EpiSwiglu {
  static constexpr bool PERM = true, AFTER_DRAIN = false;
  bf16_t* O; const float* ps_in;
  DI void operator()(const f32x4 (&acc)[2][2][4][2], const Unit& u, int wr, int wc, int fr, int fq) const {
    float rsv[2][4];
    rows_rstd(rsv, ps_in, u, wr, fr, fq, 0, 16, 1.f / 1024.f);
#pragma unroll
    for (int ai = 0; ai < 2; ++ai)
#pragma unroll
      for (int m = 0; m < 4; ++m) {
        const int row = u.pm * BM + ai * HALF + wr * 64 + m * 16 + fr;
        const float rs = rsv[ai][m];
        float o[8];
#pragma unroll
        for (int n = 0; n < 2; ++n)
#pragma unroll
          for (int c = 0; c < 4; ++c) {
            const float gv = acc[ai][0][m][n][c] * rs, uv = acc[ai][1][m][n][c] * rs;
            o[4 * n + c] = gv * __builtin_amdgcn_rcpf(1.f + __expf(-gv)) * uv;
          }
        u32x4 w; w.x = pack2(o[0], o[1]); w.y = pack2(o[2], o[3]); w.z = pack2(o[4], o[5]); w.w = pack2(o[6], o[7]);
        *(u32x4*)(O + (size_t)row * DFF + u.pn * HALF + wc * 32 + 8 * fq) = w;
      }
  }
};
template <bool FIRST, bool LAST> struct EpiResid {
  static constexpr bool PERM = true, AFTER_DRAIN = false;
  const float* xin32; bf16_t* xb; float* xout32; float* ps_out;
  DI void operator()(const f32x4 (&acc)[2][2][4][2], const Unit& u, int wr, int wc, int fr, int fq) const {
    const int row0 = u.pm * BM + wr * 64 + fr;
    const size_t base = (size_t)row0 * DM + u.pn * BM + wc * 32 + 8 * fq;
    f32x4 xv[2][4];
    u32x4 xh[2][2];
#define RES_LD(I) { const size_t o_ = base + (size_t)((((I) >> 2) * HALF) + ((I) & 3) * 16) * DM; \
    if (FIRST) { const float* p_ = xin32 + o_; xv[(I) & 1][0] = *(const f32x4*)p_; xv[(I) & 1][1] = *(const f32x4*)(p_ + 4); xv[(I) & 1][2] = *(const f32x4*)(p_ + HALF); xv[(I) & 1][3] = *(const f32x4*)(p_ + HALF + 4); } \
    else { xh[(I) & 1][0] = *(const u32x4*)(xb + o_); xh[(I) & 1][1] = *(const u32x4*)(xb + o_ + HALF); } }
    RES_LD(0)
#pragma unroll
    for (int i = 0; i < 8; ++i) {
      const int ai = i >> 2, m = i & 3;
      if (i + 1 < 8) RES_LD(i + 1)
      __builtin_amdgcn_sched_barrier(0);
      const size_t idx = base + (size_t)(ai * HALF + m * 16) * DM;
      float ssum = 0.f;
#pragma unroll
      for (int bj = 0; bj < 2; ++bj) {
        f32x4 x0, x1;
        if (FIRST) { x0 = xv[i & 1][2 * bj]; x1 = xv[i & 1][2 * bj + 1]; }
        else {
          const u32x4 hw = xh[i & 1][bj];
          x0 = (f32x4){__uint_as_float(hw.x << 16), __uint_as_float(hw.x & 0xffff0000u), __uint_as_float(hw.y << 16), __uint_as_float(hw.y & 0xffff0000u)};
          x1 = (f32x4){__uint_as_float(hw.z << 16), __uint_as_float(hw.z & 0xffff0000u), __uint_as_float(hw.w << 16), __uint_as_float(hw.w & 0xffff0000u)};
        }
        const f32x4 v0 = x0 + acc[ai][bj][m][0], v1 = x1 + acc[ai][bj][m][1];
        if (LAST) { *(f32x4*)(xout32 + idx + bj * HALF) = v0; *(f32x4*)(xout32 + idx + bj * HALF + 4) = v1; }
        else {
          ssum += (v0[0] * v0[0] + v0[1] * v0[1]) + (v0[2] * v0[2] + v0[3] * v0[3]) + (v1[0] * v1[0] + v1[1] * v1[1]) + (v1[2] * v1[2] + v1[3] * v1[3]);
          u32x4 w; w.x = pack2(v0[0], v0[1]); w.y = pack2(v0[2], v0[3]); w.z = pack2(v1[0], v1[1]); w.w = pack2(v1[2], v1[3]);
          *(u32x4*)(xb + idx + bj * HALF) = w;
        }
      }
      if (!LAST) {
        ssum += __shfl_xor(ssum, 16); ssum += __shfl_xor(ssum, 32);
        if (fq == 0) ps_out[(size_t)(row0 + ai * HALF + m * 16) * 16 + u.pn * 4 + wc] = ssum;
      }
      __builtin_amdgcn_sched_barrier(0);
    }
#undef RES_LD
  }
};

template <class Epi, class Sched>
DI void gemm_phase(PG8_LAS unsigned char* lds, const Gemm g, const Sched& S, const Epi& E) {
  const int tid = launder_tid(), wid = __builtin_amdgcn_readfirstlane(tid >> 6), lane = tid & 63, wr = wid >> 2, wc = wid & 3, fr = lane & 15, fq = lane >> 4;
  const int K = g.K, nt = K / BK;
  unsigned voffA[2], voffB[2];
#pragma unroll
  for (int i = 0; i < 2; ++i) { int R, C; stage_rc(tid * 16 + i * 8192, R, C); const int Rb = Epi::PERM ? ((R & ~31) + perm32(R & 31)) : R;
    voffA[i] = (unsigned)(R * g.lda + C) * 2u; voffB[i] = (unsigned)(Rb * K + C) * 2u; }
  const size_t kstep = (size_t)(BK * 2);
  const size_t hstepA = (size_t)HALF * g.lda * 2, hstepB = (size_t)HALF * K * 2;
  const size_t tstepA = 2 * hstepA, tstepB = 2 * hstepB;
  const unsigned ldsw = (unsigned)wid * 1024u;
  const int aoff = lds_byte(wr * 64 + fr, fq * 8), boff = lds_byte(wc * 32 + fr, fq * 8);
#define PG8_SA(b, h) (((b) * 2 + (h)) * HTB)
#define PG8_SB(b, h) ((4 + (b) * 2 + (h)) * HTB)
#define PG8_STAGE(bufoff, gbase, voff) do { _Pragma("unroll") for (int _i = 0; _i < 2; ++_i) \
    __builtin_amdgcn_global_load_lds((const unsigned*)((const char*)(gbase) + (voff)[_i]), (PG8_LAS unsigned*)(lds + (bufoff) + ldsw + _i * 8192), 16, 0, 0); } while (0)
#define PG8_LDA(dst, b, h) do { _Pragma("unroll") for (int m = 0; m < 4; ++m) _Pragma("unroll") for (int k = 0; k < 2; ++k) dst[m][k] = *(const PG8_LAS bf16x8*)(lds + PG8_SA(b, h) + aoff + m * 2048 + k * 1024); } while (0)
#define PG8_LDB(dst, b, h) do { _Pragma("unroll") for (int n = 0; n < 2; ++n) _Pragma("unroll") for (int k = 0; k < 2; ++k) dst[n][k] = *(const PG8_LAS bf16x8*)(lds + PG8_SB(b, h) + boff + n * 2048 + k * 1024); } while (0)
#define PG8_MMA(ai, bj, At, Bt) do { __builtin_amdgcn_s_setprio(1); _Pragma("unroll") for (int m = 0; m < 4; ++m) _Pragma("unroll") for (int n = 0; n < 2; ++n) _Pragma("unroll") for (int k = 0; k < 2; ++k) \
    acc[ai][bj][m][n] = __builtin_amdgcn_mfma_f32_16x16x32_bf16(Bt[n][k], At[m][k], acc[ai][bj][m][n], 0, 0, 0); __builtin_amdgcn_s_setprio(0); } while (0)
#define PG8_WAIT_V(n) asm volatile("s_waitcnt vmcnt(" #n ")" ::: "memory")
#define PG8_WAIT_L(n) asm volatile("s_waitcnt lgkmcnt(" #n ")" ::: "memory")
#define PG8_BAR __builtin_amdgcn_s_barrier()
#define PG8_SCHED __builtin_amdgcn_sched_barrier(0)
  Unit cur, nxt; int ui = 0;
  if (!S.next(0, cur)) return;
  f32x4 acc[2][2][4][2];
#pragma unroll
  for (int a = 0; a < 2; ++a)
#pragma unroll
    for (int b = 0; b < 2; ++b)
#pragma unroll
      for (int m = 0; m < 4; ++m)
#pragma unroll
        for (int n = 0; n < 2; ++n) acc[a][b][m][n] = (f32x4){0.f, 0.f, 0.f, 0.f};
  bf16x8 At[4][2], B0[2][2], B1[2][2];
  const char* cA = (const char*)g.A + (size_t)cur.pm * tstepA; const char* cB = (const char*)g.Bt + (size_t)cur.pn * tstepB;
  PG8_STAGE(PG8_SB(0, 0), cB, voffB); PG8_STAGE(PG8_SB(0, 1), cB + hstepB, voffB); PG8_STAGE(PG8_SA(0, 0), cA, voffA); PG8_STAGE(PG8_SA(0, 1), cA + hstepA, voffA);
  if (wr == 1) PG8_BAR;
  PG8_WAIT_V(2); PG8_BAR;
  PG8_STAGE(PG8_SB(1, 0), cB + kstep, voffB); PG8_STAGE(PG8_SA(1, 0), cA + kstep, voffA); PG8_STAGE(PG8_SB(1, 1), cB + hstepB + kstep, voffB);
  PG8_WAIT_V(6); PG8_BAR;
  for (;;) {
    const bool has_next = S.next(ui + 1, nxt);
    const char* nA = has_next ? (const char*)g.A + (size_t)nxt.pm * tstepA : cA; const char* nB = has_next ? (const char*)g.Bt + (size_t)nxt.pn * tstepB : cB;
#pragma unroll 1
    for (int t = 0; t < nt; t += 2) {
      const bool last = (t == nt - 2);
      const char* a1 = cA + (size_t)(t + 1) * kstep;
      const char* a2 = last ? nA : cA + (size_t)(t + 2) * kstep; const char* b2 = last ? nB : cB + (size_t)(t + 2) * kstep;
      const char* a3 = a2 + kstep; const char* b3 = b2 + kstep;
      PG8_LDB(B0, 0, 0); PG8_LDB(B1, 0, 1); PG8_SCHED; PG8_LDA(At, 0, 0); PG8_STAGE(PG8_SA(1, 1), a1 + hstepA, voffA);
      PG8_WAIT_V(8); PG8_WAIT_L(0); PG8_BAR; PG8_MMA(0, 0, At, B0); PG8_MMA(0, 1, At, B1); PG8_BAR; PG8_SCHED;
      PG8_LDA(At, 0, 1); PG8_STAGE(PG8_SB(0, 0), b2, voffB); PG8_STAGE(PG8_SB(0, 1), b2 + hstepB, voffB); PG8_STAGE(PG8_SA(0, 0), a2, voffA);
      PG8_WAIT_V(8); PG8_WAIT_L(0); PG8_BAR; PG8_MMA(1, 0, At, B0); PG8_MMA(1, 1, At, B1); PG8_BAR; PG8_SCHED;
      PG8_LDB(B0, 1, 0); PG8_LDB(B1, 1, 1); PG8_SCHED; PG8_LDA(At, 1, 0); PG8_STAGE(PG8_SA(0, 1), a2 + hstepA, voffA);
      PG8_WAIT_V(8); PG8_WAIT_L(0); PG8_BAR; PG8_MMA(0, 0, At, B0); PG8_MMA(0, 1, At, B1); PG8_BAR; PG8_SCHED;
      PG8_LDA(At, 1, 1); PG8_STAGE(PG8_SB(1, 0), b3, voffB); PG8_STAGE(PG8_SB(1, 1), b3 + hstepB, voffB); PG8_STAGE(PG8_SA(1, 0), a3, voffA);
      PG8_WAIT_V(8); PG8_WAIT_L(0); PG8_BAR; PG8_MMA(1, 0, At, B0); PG8_MMA(1, 1, At, B1); PG8_BAR; PG8_SCHED;
    }
    if (wr == 0) PG8_BAR;
    E(acc, cur, wr, wc, fr, fq);
    if (!has_next) break;
#pragma unroll
    for (int a = 0; a < 2; ++a)
#pragma unroll
      for (int b = 0; b < 2; ++b)
#pragma unroll
        for (int m = 0; m < 4; ++m)
#pragma unroll
          for (int n = 0; n < 2; ++n) acc[a][b][m][n] = (f32x4){0.f, 0.f, 0.f, 0.f};
    cur = nxt; cA = nA; cB = nB; ++ui;
    if (wr == 1) PG8_BAR;
  }
  PG8_WAIT_V(0);
  PG8_BAR;
#undef PG8_SA
#undef PG8_SB
#undef PG8_STAGE
#undef PG8_LDA
#undef PG8_LDB
#undef PG8_MMA
#undef PG8_WAIT_V
#undef PG8_WAIT_L
#undef PG8_BAR
#undef PG8_SCHED
}
}
template <int D, bool ROPE>
DI void headnorm_phase(const bf16_t* src1, int ld1, int hs1, const bf16_t* src2, int ld2, int hs2, bf16_t* dst, int ldd, int hsd,
                       const float* __restrict__ gain, int nrows, int nheads, const int* __restrict__ pos, float oscale) {
  constexpr int NM = D / 16, U = 8;
  const int tidh = launder_tid();
  const int s = tidh & 15;
  const long nitems = (long)nrows * nheads;
  const long stride = (long)gridDim.x * (NTHREADS / 16);
  float gn[NM];
#pragma unroll
  for (int m = 0; m < NM; ++m) gn[m] = gain[s + 16 * m] * oscale;
  const float invf = ROPE ? exp2f(-(float)s * (13.287712379549449f / 16.f)) : 0.f;
  for (long it0 = (long)blockIdx.x * (NTHREADS / 16) + (tidh >> 4); it0 < nitems; it0 += stride * U) {
    float v[U][NM];
    int rowv[U], hdv[U];
#pragma unroll
    for (int u = 0; u < U; ++u) {
      long it = it0 + stride * u; if (it >= nitems) it = it0;
      const int row = (int)(it / nheads), hd = (int)(it - (long)row * nheads);
      rowv[u] = row; hdv[u] = hd;
#pragma unroll
      for (int m = 0; m < NM; ++m)
        v[u][m] = (m < 4) ? bf2f(src1[(size_t)row * ld1 + hd * hs1 + s + 16 * m]) : bf2f(src2[(size_t)row * ld2 + hd * hs2 + s + 16 * (m - 4)]);
    }
#pragma unroll
    for (int u = 0; u < U; ++u) {
      float ss = 0.f;
#pragma unroll
      for (int m = 0; m < NM; ++m) ss += v[u][m] * v[u][m];
      ss += __shfl_xor(ss, 1); ss += __shfl_xor(ss, 2); ss += __shfl_xor(ss, 4); ss += __shfl_xor(ss, 8);
      const float rstd = rsqrtf(ss * (1.f / D) + EPS);
#pragma unroll
      for (int m = 0; m < NM; ++m) v[u][m] = v[u][m] * rstd * gn[m];
      if (ROPE) {
        const float ang = (float)pos[rowv[u]] * invf;
        float rev = ang * 0.15915494309189535f;
        rev = rev - floorf(rev);
        const float sn = __builtin_amdgcn_sinf(rev), cs = __builtin_amdgcn_cosf(rev);
        const float x1 = v[u][NM - 2], x2 = v[u][NM - 1];
        v[u][NM - 2] = x1 * cs - x2 * sn;
        v[u][NM - 1] = x2 * cs + x1 * sn;
      }
    }
#pragma unroll
    for (int u = 0; u < U; ++u)
#pragma unroll
      for (int m = 0; m < NM; ++m) dst[(size_t)rowv[u] * ldd + hdv[u] * hsd + s + 16 * m] = tobf(v[u][m]);
  }
}

typedef short v4i16_t __attribute__((ext_vector_type(4)));
DI s16x4 tr_read(const char* p) {
  return __builtin_bit_cast(s16x4, __builtin_amdgcn_ds_read_tr16_b64_v4i16((__attribute__((address_space(3))) v4i16_t*)p));
}
template <int DQK, int MODE, bool QN, bool KN>
DI void attn_item(const bf16_t* __restrict__ Q, int ldq, const bf16_t* __restrict__ Kp, int ldk, const bf16_t* __restrict__ Vp, int ldv,
                  int q0, int nkt, bf16_t* __restrict__ O, float scale, char* smem,
                  const float* __restrict__ gq, float oscale, const int* __restrict__ qpos, const float* __restrict__ gk) {
  constexpr int NS = DQK / 16, KROW = (DQK + 8) * 2, KBYTES = 128 * KROW, VIMG = 128 * 64, BUF = KBYTES + 2 * VIMG, NKC = DQK / 8, NKL = (128 * NKC) / NTHREADS;
  static_assert((128 * NKC) % NTHREADS == 0, "K chunks per stage must divide evenly");
  static_assert(!KN || DQK == 64, "key normalisation on load is written for 64-dim keys");
  const int tid = launder_tid(), lane = tid & 63, wave = tid >> 6, r = lane & 31, h = lane >> 5;
  const int qrow = q0 + wave * 32 + r;
  const int qwmax = q0 + wave * 32 + 31;
  bf16x8 qf[NS];
#pragma unroll
  for (int s = 0; s < NS; ++s) qf[s] = *(const bf16x8*)(Q + (size_t)(wave * 32 + r) * ldq + 16 * s + 8 * h);
  if (QN) {
    float qv[NS][8];
    float ss = 0.f;
#pragma unroll
    for (int s = 0; s < NS; ++s)
#pragma unroll
      for (int j = 0; j < 8; ++j) { qv[s][j] = bf2f((bf16_t)qf[s][j]); ss += qv[s][j] * qv[s][j]; }
    ss += __shfl_xor(ss, 32);
    const float rstd = rsqrtf(ss * (1.f / DQK) + EPS) * oscale;
#pragma unroll
    for (int s = 0; s < NS; ++s) {
      const f32x4 g0 = *(const f32x4*)(gq + 16 * s + 8 * h), g1 = *(const f32x4*)(gq + 16 * s + 8 * h + 4);
#pragma unroll
      for (int j = 0; j < 4; ++j) { qv[s][j] *= rstd * g0[j]; qv[s][4 + j] *= rstd * g1[j]; }
    }
    if (DQK == 96) {
      const float pf_ = (float)qpos[wave * 32 + r];
#pragma unroll
      for (int j = 0; j < 8; ++j) {
        const float ang = pf_ * exp2f(-(float)(8 * h + j) * (13.287712379549449f / 16.f));
        float rev = ang * 0.15915494309189535f; rev = rev - floorf(rev);
        const float sn = __builtin_amdgcn_sinf(rev), cs = __builtin_amdgcn_cosf(rev);
        const float x1 = qv[NS - 2][j], x2 = qv[NS - 1][j];
        qv[NS - 2][j] = x1 * cs - x2 * sn; qv[NS - 1][j] = x2 * cs + x1 * sn;
      }
    }
#pragma unroll
    for (int s = 0; s < NS; ++s) {
      u32x4 w; w.x = pack2(qv[s][0], qv[s][1]); w.y = pack2(qv[s][2], qv[s][3]); w.z = pack2(qv[s][4], qv[s][5]); w.w = pack2(qv[s][6], qv[s][7]);
      qf[s] = __builtin_bit_cast(bf16x8, w);
    }
  }
  f32x4 gk0 = {1.f, 1.f, 1.f, 1.f}, gk1 = {1.f, 1.f, 1.f, 1.f};
  if (KN) { gk0 = *(const f32x4*)(gk + (tid & 7) * 8); gk1 = *(const f32x4*)(gk + (tid & 7) * 8 + 4); }
  float sbound = 0.f; bool fixed_shift = false;
  if (MODE != 2 && QN) {
    float gqm = 0.f, gkm = 0.f;
#pragma unroll
    for (int s = 0; s < NS; ++s)
#pragma unroll
      for (int j = 0; j < 8; ++j) { gqm = fmaxf(gqm, fabsf(gq[16 * s + 8 * h + j])); gkm = fmaxf(gkm, fabsf(gk[16 * s + 8 * h + j])); }
    gqm = fmaxf(gqm, __shfl_xor(gqm, 32)); gkm = fmaxf(gkm, __shfl_xor(gkm, 32));
    sbound = sqrtf((float)DQK) * 1.4426950408889634f * gqm * gkm * 1.02f + 0.01f;
    fixed_shift = __builtin_amdgcn_readfirstlane(sbound < 48.f ? 1 : 0) != 0;
  }
  f32x16 o[2];
#pragma unroll
  for (int a = 0; a < 2; ++a)
#pragma unroll
    for (int i = 0; i < 16; ++i) o[a][i] = 0.f;
  float m_run = -INFINITY, l_run = 0.f, carry = 1.f;
  u32x4 rk0[NKL], rv0[2], rk1[NKL], rv1[2];
  const int vtr_off = (4 * h + ((lane & 15) >> 2)) * 64 + (((lane >> 4) & 1) * 16 + 4 * (lane & 3)) * 2;

#define AT_GLOAD(RK, RV, SG) { const int key0_ = stage_key0(SG); _Pragma("unroll") for (int i = 0; i < NKL; ++i) { const int c = tid + NTHREADS * i; const int row = c / NKC, kc = c - row * NKC; RK[i] = *(const u32x4*)(Kp + (size_t)(key0_ + row) * ldk + kc * 8); } \
    _Pragma("unroll") for (int i = 0; i < 2; ++i) { const int c = tid + NTHREADS * i; const int key = c >> 3, cc = c & 7; RV[i] = *(const u32x4*)(Vp + (size_t)(key0_ + key) * ldv + cc * 8); } }
#define AT_SWRITE(RK, RV, BUFI) { char* sK_ = smem + (BUFI) * BUF; char* sV_ = sK_ + KBYTES; _Pragma("unroll") for (int i = 0; i < NKL; ++i) { const int c = tid + NTHREADS * i; const int row = c / NKC, kc = c - row * NKC; u32x4 kw_ = RK[i]; \
      if (KN) { float kv_[8]; kv_[0] = __uint_as_float(kw_.x << 16); kv_[1] = __uint_as_float(kw_.x & 0xffff0000u); kv_[2] = __uint_as_float(kw_.y << 16); kv_[3] = __uint_as_float(kw_.y & 0xffff0000u); \
        kv_[4] = __uint_as_float(kw_.z << 16); kv_[5] = __uint_as_float(kw_.z & 0xffff0000u); kv_[6] = __uint_as_float(kw_.w << 16); kv_[7] = __uint_as_float(kw_.w & 0xffff0000u); \
        float ks_ = 0.f; _Pragma("unroll") for (int j = 0; j < 8; ++j) ks_ += kv_[j] * kv_[j]; \
        ks_ += __shfl_xor(ks_, 1); ks_ += __shfl_xor(ks_, 2); ks_ += __shfl_xor(ks_, 4); const float kr_ = rsqrtf(ks_ * (1.f / 64.f) + EPS); \
        kw_.x = pack2(kv_[0] * kr_ * gk0[0], kv_[1] * kr_ * gk0[1]); kw_.y = pack2(kv_[2] * kr_ * gk0[2], kv_[3] * kr_ * gk0[3]); \
        kw_.z = pack2(kv_[4] * kr_ * gk1[0], kv_[5] * kr_ * gk1[1]); kw_.w = pack2(kv_[6] * kr_ * gk1[2], kv_[7] * kr_ * gk1[3]); } \
      *(u32x4*)(sK_ + row * KROW + kc * 16) = kw_; } \
    _Pragma("unroll") for (int i = 0; i < 2; ++i) { const int c = tid + NTHREADS * i; const int key = c >> 3, cc = c & 7; *(u32x4*)(sV_ + (cc >> 2) * VIMG + key * 64 + (cc & 3) * 16) = RV[i]; } }
  const int nsg = nkt >> 1;
  auto tile_of = [&](int it) { return MODE == 2 ? (nkt - 1 - it) : it; };
  auto stage_key0 = [&](int sg) { const int sc = sg < nsg ? sg : nsg - 1; return 128 * (MODE == 2 ? (nsg - 1 - sc) : sc); };

  AT_GLOAD(rk0, rv0, 0)
  AT_GLOAD(rk1, rv1, 1)
  AT_SWRITE(rk0, rv0, 0)
  __syncthreads();
  auto compute = [&](int it, int bufi) {
    const int kt = tile_of(it);
    const int koff = (kt & 1) * 64;
    const char* sK = smem + bufi * BUF + koff * KROW;
    const char* sV = smem + bufi * BUF + KBYTES + koff * 64;
    bool active = (MODE == 0) || (kt * 64 <= qwmax);
    if (MODE == 2 && active) active = __builtin_amdgcn_ballot_w64(carry >= 1.17549435e-38f) != 0;
    if (active) {
      f32x16 sacc[2];
      const float sinit = fixed_shift ? -sbound : 0.f;
#pragma unroll
      for (int kb = 0; kb < 2; ++kb) {
#pragma unroll
        for (int i = 0; i < 16; ++i) sacc[kb][i] = sinit;
#pragma unroll
        for (int s = 0; s < NS; ++s) {
          const bf16x8 kf = *(const bf16x8*)(sK + (kb * 32 + r) * KROW + s * 32 + h * 16);
          sacc[kb] = MFMA32(kf, qf[s], sacc[kb]);
        }
      }
      const bool diag = (MODE != 0) && (kt * 64 + 63 >= q0 + wave * 32);
      if (MODE != 0 && diag) {
#pragma unroll
        for (int kb = 0; kb < 2; ++kb)
#pragma unroll
          for (int i = 0; i < 16; ++i) {
            const int key = kt * 64 + kb * 32 + (i & 3) + 8 * (i >> 2) + 4 * h;
            if (MODE == 1 ? (key > qrow) : (key >= qrow)) sacc[kb][i] = -INFINITY;
          }
      }
      if (MODE == 2) {
        float beta[2][16], ff[2][16];
#pragma unroll
        for (int kb = 0; kb < 2; ++kb)
#pragma unroll
          for (int i = 0; i < 16; ++i) {
            const float z = sacc[kb][i] * scale;
            const float tt = __builtin_amdgcn_exp2f(-fabsf(z) * 1.4426950408889634f);
            const float rr = __builtin_amdgcn_rcpf(1.f + tt);
            const float trr = tt * rr;
            float b = z >= 0.f ? rr : trr, f = z >= 0.f ? trr : rr;
            beta[kb][i] = b; ff[kb][i] = f;
          }
        float cp[8], cpo[8], sp[8];
#pragma unroll
        for (int m = 0; m < 8; ++m) { const int kb = m >> 2, g = m & 3; cp[m] = (ff[kb][4 * g] * ff[kb][4 * g + 1]) * (ff[kb][4 * g + 2] * ff[kb][4 * g + 3]); }
#pragma unroll
        for (int m = 0; m < 8; ++m) cpo[m] = __shfl_xor(cp[m], 32);
        float run = carry;
#pragma unroll
        for (int m = 7; m >= 0; --m) { sp[m] = run; run *= (cp[m] * cpo[m]); }
        carry = run;
#pragma unroll
        for (int m = 0; m < 8; ++m) {
          const int kb = m >> 2, g = m & 3;
          float tq = sp[m] * (h == 0 ? cpo[m] : 1.f);
#pragma unroll
          for (int c = 3; c >= 0; --c) { sacc[kb][4 * g + c] = beta[kb][4 * g + c] * tq; tq *= ff[kb][4 * g + c]; }
        }
      } else if (fixed_shift) {
        float ps = 0.f;
#pragma unroll
        for (int kb = 0; kb < 2; ++kb)
#pragma unroll
          for (int i = 0; i < 16; ++i) { const float pv = __builtin_amdgcn_exp2f(sacc[kb][i]); sacc[kb][i] = pv; ps += pv; }
        l_run += ps;
      } else {
        float tmax = -INFINITY;
#pragma unroll
        for (int kb = 0; kb < 2; ++kb)
#pragma unroll
          for (int i = 0; i < 16; ++i) {
            tmax = fmaxf(tmax, sacc[kb][i]);
          }
        tmax = fmaxf(tmax, __shfl_xor(tmax, 32));
        const float m_new = fmaxf(m_run, tmax);
        const float alpha = __builtin_amdgcn_exp2f(m_run - m_new);
        m_run = m_new;
        float ps = 0.f;
#pragma unroll
        for (int kb = 0; kb < 2; ++kb)
#pragma unroll
          for (int i = 0; i < 16; ++i) { const float pv = __builtin_amdgcn_exp2f(sacc[kb][i] - m_new); sacc[kb][i] = pv; ps += pv; }
        l_run = l_run * alpha + ps;
        if (__builtin_amdgcn_ballot_w64(alpha != 1.f) != 0) {
#pragma unroll
          for (int a = 0; a < 2; ++a)
#pragma unroll
            for (int i = 0; i < 16; ++i) o[a][i] *= alpha;
        }
      }
#pragma unroll
      for (int kb = 0; kb < 2; ++kb)
#pragma unroll
        for (int s2 = 0; s2 < 2; ++s2) {
          u32x4 pw;
          pw.x = pack2(sacc[kb][8 * s2 + 0], sacc[kb][8 * s2 + 1]); pw.y = pack2(sacc[kb][8 * s2 + 2], sacc[kb][8 * s2 + 3]);
          pw.z = pack2(sacc[kb][8 * s2 + 4], sacc[kb][8 * s2 + 5]); pw.w = pack2(sacc[kb][8 * s2 + 6], sacc[kb][8 * s2 + 7]);
          const bf16x8 pf = __builtin_bit_cast(bf16x8, pw);
#pragma unroll
          for (int dvb = 0; dvb < 2; ++dvb) {
            const char* vb = sV + dvb * VIMG + (kb * 32 + 16 * s2) * 64 + vtr_off;
            const s16x4 v0 = tr_read(vb), v1 = tr_read(vb + 8 * 64);
            const bf16x8 vf = __builtin_shufflevector(v0, v1, 0, 1, 2, 3, 4, 5, 6, 7);
            o[dvb] = MFMA32(vf, pf, o[dvb]);
          }
        }
    }
  };
#define AT_SB __builtin_amdgcn_sched_barrier(0);
  for (int sg = 0; sg < nsg; sg += 2) {
    AT_SB AT_GLOAD(rk0, rv0, sg + 2)
    AT_SB compute(2 * sg, 0); compute(2 * sg + 1, 0); AT_SB
    AT_SWRITE(rk1, rv1, 1)
    if (MODE == 2) { if (__syncthreads_and(carry < 1.17549435e-38f)) break; } else { __syncthreads(); }
    AT_SB AT_GLOAD(rk1, rv1, sg + 3)
    AT_SB compute(2 * sg + 2, 1); compute(2 * sg + 3, 1); AT_SB
    AT_SWRITE(rk0, rv0, 0)
    if (MODE == 2) { if (__syncthreads_and(carry < 1.17549435e-38f)) break; } else { __syncthreads(); }
  }
#undef AT_SB
  float inv = 1.f;
  if (MODE != 2) { const float lt = l_run + __shfl_xor(l_run, 32); inv = 1.f / lt; }
#pragma unroll
  for (int dvb = 0; dvb < 2; ++dvb)
#pragma unroll
    for (int g = 0; g < 4; ++g) {
      u32x2 w;
      w.x = pack2(o[dvb][4 * g] * inv, o[dvb][4 * g + 1] * inv); w.y = pack2(o[dvb][4 * g + 2] * inv, o[dvb][4 * g + 3] * inv);
      *(u32x2*)(O + (size_t)(wave * 32 + r) * DM + dvb * 32 + 8 * g + 4 * h) = w;
    }
  __syncthreads();
}

template <int LAYER>
DI void attn_phase(const Params& p, char* smem) {
  char* ws = p.ws;
  bf16_t* mix = (bf16_t*)(ws + O_MIX);
  const int xcd = (int)(blockIdx.x & 7), lb = (int)(blockIdx.x >> 3), L = (int)(gridDim.x >> 3);
  for (int j = lb; j < 192 + 64; j += L) {
    if (j < 192) {
      const int hl = j >> 4, qi = j & 15, qt = ((j / L) & 1) ? (15 - qi) : qi, bh = hl * 8 + xcd, b = bh / 12, hd = bh % 12, q0 = qt * 256;
      const size_t tok0 = (size_t)b * SEQ;
      bf16_t* O = mix + (tok0 + q0) * DM + hd * 64;
      if (LAYER == 0) {
        const bf16_t* P = (const bf16_t*)(ws + O_P);
        attn_item<64, 2, false, false>(P + (tok0 + q0) * 2560 + hd * 64, 2560, P + tok0 * 2560 + 768 + hd * 64, 2560, P + tok0 * 2560 + 1536 + hd * 64, 2560,
                                       q0, q0 / 64 + 4, O, 0.125f, smem, nullptr, 1.f, nullptr, nullptr);
      } else {
        const bf16_t* Qb = (const bf16_t*)(ws + O_QB);
        const bf16_t* Kn = (const bf16_t*)(ws + O_KN);
        const bf16_t* V1 = (const bf16_t*)(ws + O_V1);
        attn_item<96, 1, true, false>(Qb + (tok0 + q0) * 1152 + hd * 96, 1152, Kn + tok0 * 1152 + hd * 96, 1152, V1 + tok0 * 768 + hd * 64, 768,
                                      q0, q0 / 64 + 4, O, 1.f, smem, p.mla_g_qn, 0.14724138410008716f, p.pos + tok0 + q0, p.mla_g_kn);
      }
    } else {
      const int j2 = j - 192, qt = j2 & 15, hm = j2 >> 4, b = xcd, q0 = qt * 256;
      const size_t tok0 = (size_t)b * SEQ;
      bf16_t* O = mix + (tok0 + q0) * DM + 768 + hm * 64;
      const bf16_t* KR = (const bf16_t*)(ws + O_KMRAW) + (size_t)LAYER * 2048 * 512 + (size_t)(b * 256) * 512 + hm * 128;
      const bf16_t* Qm = LAYER == 0 ? (const bf16_t*)(ws + O_P) + (tok0 + q0) * 2560 + 2304 + hm * 64 : (const bf16_t*)(ws + O_PM) + (tok0 + q0) * 1408 + 1056 + hm * 64;
      attn_item<64, 0, true, true>(Qm, LAYER == 0 ? 2560 : 1408, KR, 512, KR + 64, 512, q0, 4, O, 1.f, smem,
                                   p.g_qn_mem + LAYER * 64, 0.18033688011112042f, nullptr, p.g_kn_mem + LAYER * 64);
    }
  }
}

__global__ void __launch_bounds__(NTHREADS, 2) fwd_megakernel(Params p) {
  extern __shared__ __attribute__((aligned(16))) char smem[];
  cg::grid_group grid = cg::this_grid();
  char* ws = p.ws;
  int toff = 0;
  __shared__ uint4 xb_words;
  if (threadIdx.x == 0) xb_words = make_uint4(0u, 0u, 0u, 0u);
  __syncthreads();
  const XcdBarrier xb = xcd_barrier_post((unsigned*)(ws + O_BAR), (volatile LAS unsigned*)&xb_words);
  PG8_LAS unsigned char* lds = (PG8_LAS unsigned char*)smem;
  float* ps1 = (float*)(ws + O_PS1); float* ps2 = (float*)(ws + O_PS2);
  transpose_job<true>(p.sb_w_in, p.ln_attn, (bf16_t*)(ws + O_SBIN), 1024, 2560, 2560, 0, smem, toff);
  transpose_job<false>(p.w_out, nullptr, (bf16_t*)(ws + O_OUT0), 1024, 1024, 1024, 0, smem, toff);
  transpose_job<false>(p.w_out + (size_t)1024 * 1024, nullptr, (bf16_t*)(ws + O_OUT1), 1024, 1024, 1024, 0, smem, toff);
  transpose_job<true>(p.w_mem_kv, p.ln_mem, (bf16_t*)(ws + O_MKV0), 1024, 512, 512, 0, smem, toff);
  transpose_job<true>(p.w_mem_kv + (size_t)1024 * 512, p.ln_mem + 1024, (bf16_t*)(ws + O_MKV1), 1024, 512, 512, 0, smem, toff);
  transpose_job<true>(p.w_ffn_gu, p.ln_ffn, (bf16_t*)(ws + O_GU0), 1024, 5632, 5632, 1, smem, toff);
  transpose_job<true>(p.w_ffn_gu + (size_t)1024 * 5632, p.ln_ffn + 1024, (bf16_t*)(ws + O_GU1), 1024, 5632, 5632, 1, smem, toff);
  transpose_job<false>(p.w_ffn_down, nullptr, (bf16_t*)(ws + O_DN0), 2816, 1024, 1024, 0, smem, toff);
  transpose_job<false>(p.w_ffn_down + (size_t)2816 * 1024, nullptr, (bf16_t*)(ws + O_DN1), 2816, 1024, 1024, 0, smem, toff);
  transpose_job<true>(p.mla_w_in, p.ln_attn + 1024, (bf16_t*)(ws + O_MLAIN), 1024, 1312, 1536, 0, smem, toff);
  transpose_job<true>(p.mla_w_q_up, p.mla_q_norm, (bf16_t*)(ws + O_QUP), 768, 1152, 1280, 0, smem, toff);
  transpose_job<true>(p.mla_w_kv_up, p.mla_kv_norm, (bf16_t*)(ws + O_KVUP), 256, 1536, 1536, 0, smem, toff);
  convert_rows(p.x, (bf16_t*)(ws + O_XB), T_TOK, false, ps1);
  convert_rows(p.mem, (bf16_t*)(ws + O_MEMN), 2048, true, nullptr);
  if (p.ws == nullptr) grid.sync();
  xcd_barrier(xb);
  toff = 0;
  {
    pg8::Gemm g{(const bf16_t*)(ws + O_XB), 1024, (const bf16_t*)(ws + O_SBIN), T_TOK, 2560, 1024};
    pg8::XOrder S; S.init(T_TOK, 2560, toff);
    pg8::EpiNorm<pg8::EM_PLAIN> E{(bf16_t*)(ws + O_P), 2560, 2560, nullptr, ps1, 0, 16, 1.f / 1024.f, nullptr};
    pg8::gemm_phase(lds, g, S, E);
    for (int l = 0; l < 2; ++l) {
      pg8::Gemm gm{(const bf16_t*)(ws + O_MEMN), 1024, (const bf16_t*)(ws + (l ? O_MKV1 : O_MKV0)), 2048, 512, 1024};
      pg8::XOrder Sm; Sm.init(2048, 512, toff);
      pg8::EpiNorm<pg8::EM_PLAIN> Em{(bf16_t*)(ws + O_KMRAW) + (size_t)l * 2048 * 512, 512, 512, nullptr, nullptr, 0, 0, 0.f, nullptr};
      pg8::gemm_phase(lds, gm, Sm, Em);
    }
  }
  xcd_barrier(xb);
  attn_phase<0>(p, smem);
  xcd_barrier(xb);
  toff = 0;
  {
    pg8::Gemm g{(const bf16_t*)(ws + O_MIX), 1024, (const bf16_t*)(ws + O_OUT0), T_TOK, 1024, 1024};
    pg8::XOrder S; S.init(T_TOK, 1024, toff);
    pg8::EpiResid<true, false> E{p.x, (bf16_t*)(ws + O_XB), nullptr, ps1};
    pg8::gemm_phase(lds, g, S, E);
  }
  xcd_barrier(xb);
  toff = 0;
  {
    pg8::Gemm g{(const bf16_t*)(ws + O_XB), 1024, (const bf16_t*)(ws + O_GU0), T_TOK, 5632, 1024};
    pg8::XOrder S; S.init(T_TOK, 5632, toff);
    pg8::EpiSwiglu E{(bf16_t*)(ws + O_ACT), ps1};
    pg8::gemm_phase(lds, g, S, E);
  }
  xcd_barrier(xb);
  toff = 0;
  {
    pg8::Gemm g{(const bf16_t*)(ws + O_ACT), 2816, (const bf16_t*)(ws + O_DN0), T_TOK, 1024, 2816};
    pg8::XOrder S; S.init(T_TOK, 1024, toff);
    pg8::EpiResid<false, false> E{nullptr, (bf16_t*)(ws + O_XB), nullptr, ps1};
    pg8::gemm_phase(lds, g, S, E);
  }
  xcd_barrier(xb);
  toff = 0;
  {
    pg8::Gemm g{(const bf16_t*)(ws + O_XB), 1024, (const bf16_t*)(ws + O_MLAIN), T_TOK, 1536, 1024};
    pg8::XOrder S; S.init(T_TOK, 1536, toff);
    pg8::EpiNorm<pg8::EM_PLAIN, true> E{(bf16_t*)(ws + O_PM), 1408, 1408, nullptr, ps1, 0, 16, 1.f / 1024.f, ps2};
    pg8::gemm_phase(lds, g, S, E);
  }
  xcd_barrier(xb);
  toff = 0;
  {
    pg8::Gemm g{(const bf16_t*)(ws + O_PM), 1408, (const bf16_t*)(ws + O_QUP), T_TOK, 1280, 768};
    pg8::XOrder S; S.init(T_TOK, 1280, toff);
    pg8::EpiNorm<pg8::EM_PLAIN> E{(bf16_t*)(ws + O_QB), 1152, 1152, nullptr, ps2, 0, 12, 1.f / 768.f, nullptr};
    pg8::gemm_phase(lds, g, S, E);
    pg8::Gemm g2{(const bf16_t*)(ws + O_PM) + 768, 1408, (const bf16_t*)(ws + O_KVUP), T_TOK, 1536, 256};
    pg8::XOrder S2; S2.init(T_TOK, 1536, toff, (gridDim.x == 256) ? 1 : 0);
    pg8::EpiNorm<pg8::EM_KVUP> E2{(bf16_t*)(ws + O_KN), 1152, 1536, (bf16_t*)(ws + O_V1), ps2, 12, 16, 1.f / 256.f, nullptr};
    pg8::gemm_phase(lds, g2, S2, E2);
  }
  xcd_barrier(xb);
  {
    bf16_t* kn = (bf16_t*)(ws + O_KN); bf16_t* pm = (bf16_t*)(ws + O_PM);
    headnorm_phase<96, true>(kn, 1152, 96, pm + 1024, 1408, 0, kn, 1152, 96, p.mla_g_kn, T_TOK, 12, p.pos, 1.f);
  }
  xcd_barrier(xb);
  attn_phase<1>(p, smem);
  xcd_barrier(xb);
  toff = 0;
  {
    pg8::Gemm g{(const bf16_t*)(ws + O_MIX), 1024, (const bf16_t*)(ws + O_OUT1), T_TOK, 1024, 1024};
    pg8::XOrder S; S.init(T_TOK, 1024, toff);
    pg8::EpiResid<false, false> E{nullptr, (bf16_t*)(ws + O_XB), nullptr, ps1};
    pg8::gemm_phase(lds, g, S, E);
  }
  xcd_barrier(xb);
  toff = 0;
  {
    pg8::Gemm g{(const bf16_t*)(ws + O_XB), 1024, (const bf16_t*)(ws + O_GU1), T_TOK, 5632, 1024};
    pg8::XOrder S; S.init(T_TOK, 5632, toff);
    pg8::EpiSwiglu E{(bf16_t*)(ws + O_ACT), ps1};
    pg8::gemm_phase(lds, g, S, E);
  }
  xcd_barrier(xb);
  toff = 0;
  {
    pg8::Gemm g{(const bf16_t*)(ws + O_ACT), 2816, (const bf16_t*)(ws + O_DN1), T_TOK, 1024, 2816};
    pg8::XOrder S; S.init(T_TOK, 1024, toff);
    pg8::EpiResid<false, true> E{nullptr, (bf16_t*)(ws + O_XB), p.out, nullptr};
    pg8::gemm_phase(lds, g, S, E);
  }
}

extern "C" void kernel_launch(void* const* d_in, const int* in_sizes, int n_in, void* d_out, int out_size, void* d_ws, size_t ws_size,
                              hipStream_t stream) {
  static int grid_blocks = 0;
  if (!grid_blocks) {
    (void)hipFuncSetAttribute((const void*)fwd_megakernel, hipFuncAttributeMaxDynamicSharedMemorySize, LDS_BYTES);
    int dev = 0, cus = 0, per_cu = 0;
    (void)hipGetDevice(&dev);
    (void)hipDeviceGetAttribute(&cus, hipDeviceAttributeMultiprocessorCount, dev);
    (void)hipOccupancyMaxActiveBlocksPerMultiprocessor(&per_cu, fwd_megakernel, NTHREADS, LDS_BYTES);
    if (per_cu > 1) per_cu = 1;
    if (per_cu < 1) per_cu = 1;
    grid_blocks = cus * per_cu;
  }
  Params p;
  std::memset((void*)&p, 0, sizeof(p));
  p.x = (const float*)d_in[0]; p.mem = (const float*)d_in[1]; p.pos = (const int*)d_in[2];
  p.ln_attn = (const float*)d_in[3]; p.w_out = (const float*)d_in[4]; p.ln_mem = (const float*)d_in[5]; p.w_mem_kv = (const float*)d_in[6];
  p.g_qn_mem = (const float*)d_in[7]; p.g_kn_mem = (const float*)d_in[8]; p.ln_ffn = (const float*)d_in[9]; p.w_ffn_gu = (const float*)d_in[10];
  p.w_ffn_down = (const float*)d_in[11]; p.sb_w_in = (const float*)d_in[12]; p.mla_w_in = (const float*)d_in[13]; p.mla_q_norm = (const float*)d_in[14];
  p.mla_w_q_up = (const float*)d_in[15]; p.mla_kv_norm = (const float*)d_in[16]; p.mla_w_kv_up = (const float*)d_in[17];
  p.mla_g_qn = (const float*)d_in[18]; p.mla_g_kn = (const float*)d_in[19];
  p.out = (float*)d_out; p.ws = (char*)d_ws;
  (void)hipMemsetAsync((char*)d_ws + O_BAR, 0, XCD_BAR_WORDS * sizeof(unsigned), stream);
  void* args[] = {&p};
  hipError_t e = hipLaunchCooperativeKernel((const void*)fwd_megakernel, dim3(grid_blocks), dim3(NTHREADS), args, LDS_BYTES, stream);
  if (e != hipSuccess) fprintf(stderr, "cooperative launch failed: %s (grid %d)\n", hipGetErrorString(e), grid_blocks);
}
```
